# Optimizing an MI355X kernel written in HIP

```python
import math
import jax
import jax.numpy as jnp
from jax import lax
import numpy as np

D_MODEL = 1024
BATCH = 4
SEQ = 8192
DEPTH = 1
DEC_BATCH = 16
DEC_SEQ = 4096
PAST_LEN = 128

MEM_TOKENS = 256
MIX_WIDTH = D_MODEL
DIFF_WIDTH = MIX_WIDTH // 2
SSM_WIDTH = MIX_WIDTH - DIFF_WIDTH
DIFF_HEAD_DIM = 64
DIFF_HEADS = DIFF_WIDTH // (2 * DIFF_HEAD_DIM)
SSM_GROUP = 16
SSM_GROUPS = SSM_WIDTH // SSM_GROUP
SSM_STATE = 64
N_BUCKETS = 32
MAX_DISTANCE = 128
Q_BLOCK = 128
MEM_HEADS = 4
MEM_HEAD_DIM = D_MODEL // MEM_HEADS
D_FF = 2816
IN_WIDTH = 3 * DIFF_WIDTH + SSM_WIDTH
ALPHA = (2 * DEPTH) ** 0.25
BETA = (8 * DEPTH) ** -0.25
LN_EPS = 1e-5
SUBLN_EPS = 1e-5

kernel_name = 'hybrid_diffattn_s5_macaron_encoder'


def layer_norm(x, g, b):
    xf = x.astype(jnp.float32)
    mu = jnp.mean(xf, axis=-1, keepdims=True)
    var = jnp.mean(jnp.square(xf - mu), axis=-1, keepdims=True)
    y = (xf - mu) * lax.rsqrt(var + LN_EPS) * g.astype(jnp.float32) + b.astype(jnp.float32)
    return y.astype(x.dtype)


def swiglu(x, w13, w2):
    a, b = jnp.split(x @ w13, 2, axis=-1)
    return (jax.nn.silu(a) * b) @ w2


def rel_bucket(rel):
    half = N_BUCKETS // 2
    max_exact = half // 2
    ret = jnp.where(rel > 0, half, 0).astype(jnp.int32)
    n = jnp.abs(rel)
    nf = jnp.maximum(n, 1).astype(jnp.float32)
    large = max_exact + (jnp.log(nf / max_exact) / math.log(MAX_DISTANCE / max_exact)
                         * (half - max_exact)).astype(jnp.int32)
    large = jnp.minimum(large, half - 1)
    return ret + jnp.where(n < max_exact, n, large)


def diff_attention(q, k, v, lam, lam_init, subln_g, rel_bias):
    bsz, seq = q.shape[0], q.shape[1]
    nblk = seq // Q_BLOCK
    scale = DIFF_HEAD_DIM ** -0.5
    qb = q.reshape(bsz, nblk, Q_BLOCK, DIFF_HEADS, 2, DIFF_HEAD_DIM).transpose(1, 0, 2, 3, 4, 5)
    starts = jnp.arange(nblk, dtype=jnp.int32) * Q_BLOCK
    kpos = jnp.arange(seq, dtype=jnp.int32)
    table = rel_bias.astype(jnp.float32)

    def block(args):
        q_blk, s0 = args
        qpos = s0 + jnp.arange(Q_BLOCK, dtype=jnp.int32)
        bucket = rel_bucket(kpos[None, :] - qpos[:, None])
        bias = jnp.take(table, bucket, axis=0).transpose(2, 0, 1)
        s = jnp.einsum('bqhmd,bkhmd->bhmqk', q_blk, k).astype(jnp.float32) * scale
        p = jax.nn.softmax(s + bias[None, :, None], axis=-1)
        w = p[:, :, 0] - lam * p[:, :, 1]
        return jnp.einsum('bhqk,bkhe->bqhe', w.astype(v.dtype), v)

    o = lax.map(block, (qb, starts))
    o = o.transpose(1, 0, 2, 3, 4).reshape(bsz, seq, DIFF_HEADS, 2 * DIFF_HEAD_DIM)
    of = o.astype(jnp.float32)
    of = of * lax.rsqrt(jnp.mean(jnp.square(of), axis=-1, keepdims=True) + SUBLN_EPS)
    of = of * subln_g.astype(jnp.float32) * (1.0 - lam_init)
    return of.reshape(bsz, seq, DIFF_WIDTH).astype(q.dtype)


def _ssm_combine(c1, c2):
    a1, b1 = c1
    a2, b2 = c2
    return a1 * a2, a2 * b1 + b2


def s5_scan(u, lam_re, lam_im, log_step, b_re, b_im, c_re, c_im, reverse):
    f32 = jnp.float32
    lam = lax.complex(lam_re.astype(f32), lam_im.astype(f32))
    step = jnp.exp(log_step.astype(f32))[:, None]
    a_bar = jnp.exp(lam * step)
    b = lax.complex(b_re.astype(f32), b_im.astype(f32))
    b_bar = ((a_bar - 1.0) / lam)[..., None] * b
    bu = jnp.einsum('blgh,gph->blgp', u, b_bar)
    a = jnp.broadcast_to(a_bar, bu.shape)
    _, states = lax.associative_scan(_ssm_combine, (a, bu), reverse=reverse, axis=1)
    c = lax.complex(c_re.astype(f32), c_im.astype(f32))
    return jnp.einsum('blgp,ghp->blgh', states, c).real


def s5_mixer(u, lam_re, lam_im, log_step, b_re, b_im, c_re, c_im, d, glu_w, glu_b):
    bsz, seq = u.shape[0], u.shape[1]
    uf = u.astype(jnp.float32)
    ug = uf.reshape(bsz, seq, SSM_GROUPS, SSM_GROUP)
    y_fwd = s5_scan(ug, lam_re[0], lam_im[0], log_step[0], b_re[0], b_im[0], c_re[0], c_im[0], False)
    y_bwd = s5_scan(ug, lam_re[1], lam_im[1], log_step[1], b_re[1], b_im[1], c_re[1], c_im[1], True)
    y = (y_fwd + y_bwd).reshape(bsz, seq, SSM_WIDTH) + d.astype(jnp.float32) * uf
    z = jax.nn.gelu(y).astype(u.dtype)
    return z * jax.nn.sigmoid(z @ glu_w + glu_b)


def memory_attention(x, mem, wq, wkv, wo):
    bsz, seq = x.shape[0], x.shape[1]
    m = mem.shape[1]
    q = (x @ wq).reshape(bsz, seq, MEM_HEADS, MEM_HEAD_DIM)
    k, v = jnp.split(mem @ wkv, 2, axis=-1)
    k = k.reshape(bsz, m, MEM_HEADS, MEM_HEAD_DIM)
    v = v.reshape(bsz, m, MEM_HEADS, MEM_HEAD_DIM)
    s = jnp.einsum('bqhd,bkhd->bhqk', q, k).astype(jnp.float32) * (MEM_HEAD_DIM ** -0.5)
    p = jax.nn.softmax(s, axis=-1)
    o = jnp.einsum('bhqk,bkhd->bqhd', p.astype(v.dtype), v).reshape(bsz, seq, D_MODEL)
    return o @ wo


def encoder_trunk(x, mem, p):
    bsz, seq = x.shape[0], x.shape[1]
    for l in range(DEPTH):
        lam_init = 0.8 - 0.6 * math.exp(-0.3 * l)
        x = layer_norm(ALPHA * x + 0.5 * swiglu(x, p['ffn1_w13'][l], p['ffn1_w2'][l]),
                       p['ln_ffn1_g'][l], p['ln_ffn1_b'][l])
        h = x @ p['w_in'][l]
        q = h[..., :DIFF_WIDTH].reshape(bsz, seq, DIFF_HEADS, 2, DIFF_HEAD_DIM)
        k = h[..., DIFF_WIDTH:2 * DIFF_WIDTH].reshape(bsz, seq, DIFF_HEADS, 2, DIFF_HEAD_DIM)
        v = h[..., 2 * DIFF_WIDTH:3 * DIFF_WIDTH].reshape(bsz, seq, DIFF_HEADS, 2 * DIFF_HEAD_DIM)
        u = h[..., 3 * DIFF_WIDTH:]
        dl = p['diff_lambda'][l].astype(jnp.float32)
        lam = jnp.exp(jnp.sum(dl[0] * dl[1])) - jnp.exp(jnp.sum(dl[2] * dl[3])) + lam_init
        o_diff = diff_attention(q, k, v, lam, lam_init, p['diff_subln_g'][l], p['rel_bias'])
        o_ssm = s5_mixer(u, p['ssm_lam_re'][l], p['ssm_lam_im'][l], p['ssm_log_step'][l],
                         p['ssm_b_re'][l], p['ssm_b_im'][l], p['ssm_c_re'][l], p['ssm_c_im'][l],
                         p['ssm_d'][l], p['ssm_glu_w'][l], p['ssm_glu_b'][l])
        mix = jnp.concatenate([o_diff, o_ssm], axis=-1) @ p['w_out'][l]
        x = layer_norm(ALPHA * x + mix, p['ln_mix_g'][l], p['ln_mix_b'][l])
        x = layer_norm(ALPHA * x + memory_attention(x, mem, p['mem_wq'][l], p['mem_wkv'][l], p['mem_wo'][l]),
                       p['ln_mem_g'][l], p['ln_mem_b'][l])
        x = layer_norm(ALPHA * x + 0.5 * swiglu(x, p['ffn2_w13'][l], p['ffn2_w2'][l]),
                       p['ln_ffn2_g'][l], p['ln_ffn2_b'][l])
    return x


def setup_inputs(seed: int = 0) -> dict:
    key = jax.random.key(seed)
    keys = iter(jax.random.split(key, 64))
    f32 = jnp.float32

    def nrm(shape, scale):
        return jax.random.normal(next(keys), shape, f32) * scale

    def gain():
        return 1.0 + nrm((DEPTH, D_MODEL), 0.02)

    def bias():
        return nrm((DEPTH, D_MODEL), 0.02)

    d_in = D_MODEL ** -0.5
    in_col_scale = jnp.concatenate([jnp.ones((2 * DIFF_WIDTH,), f32),
                                    jnp.full((DIFF_WIDTH,), BETA, f32),
                                    jnp.ones((SSM_WIDTH,), f32)])
    kv_col_scale = jnp.concatenate([jnp.ones((D_MODEL,), f32), jnp.full((D_MODEL,), BETA, f32)])
    state_idx = jnp.arange(SSM_STATE, dtype=f32)
    ssm_shape = (DEPTH, 2, SSM_GROUPS, SSM_STATE)
    log_step = jax.random.uniform(next(keys), (DEPTH, 2, SSM_GROUPS), f32,
                                  math.log(1e-3), math.log(1e-1))
    return {
        'x_prompt': nrm((BATCH, SEQ, D_MODEL), 1.0),
        'x_sample': nrm((DEC_BATCH, DEC_SEQ, D_MODEL), 1.0),
        'mem_prompt': nrm((BATCH, MEM_TOKENS, D_MODEL), 1.0),
        'mem_sample': nrm((DEC_BATCH, MEM_TOKENS, D_MODEL), 1.0),
        'ffn1_w13': nrm((DEPTH, D_MODEL, 2 * D_FF), d_in * BETA),
        'ffn1_w2': nrm((DEPTH, D_FF, D_MODEL), D_FF ** -0.5 * BETA),
        'ln_ffn1_g': gain(),
        'ln_ffn1_b': bias(),
        'w_in': nrm((DEPTH, D_MODEL, IN_WIDTH), d_in) * in_col_scale,
        'diff_lambda': nrm((DEPTH, 4, DIFF_HEAD_DIM), 0.1),
        'diff_subln_g': 1.0 + nrm((DEPTH, 2 * DIFF_HEAD_DIM), 0.02),
        'rel_bias': nrm((N_BUCKETS, DIFF_HEADS), 0.1),
        'ssm_lam_re': -0.5 + nrm(ssm_shape, 0.01),
        'ssm_lam_im': math.pi * state_idx + nrm(ssm_shape, 0.01),
        'ssm_log_step': log_step,
        'ssm_b_re': nrm((DEPTH, 2, SSM_GROUPS, SSM_STATE, SSM_GROUP), (2 * SSM_GROUP) ** -0.5),
        'ssm_b_im': nrm((DEPTH, 2, SSM_GROUPS, SSM_STATE, SSM_GROUP), (2 * SSM_GROUP) ** -0.5),
        'ssm_c_re': nrm((DEPTH, 2, SSM_GROUPS, SSM_GROUP, SSM_STATE), 2.0 * (2 * SSM_STATE) ** -0.5),
        'ssm_c_im': nrm((DEPTH, 2, SSM_GROUPS, SSM_GROUP, SSM_STATE), 2.0 * (2 * SSM_STATE) ** -0.5),
        'ssm_d': nrm((DEPTH, SSM_WIDTH), 1.0),
        'ssm_glu_w': nrm((DEPTH, SSM_WIDTH, SSM_WIDTH), SSM_WIDTH ** -0.5),
        'ssm_glu_b': nrm((DEPTH, SSM_WIDTH), 0.01),
        'w_out': nrm((DEPTH, MIX_WIDTH, D_MODEL), MIX_WIDTH ** -0.5 * BETA),
        'ln_mix_g': gain(),
        'ln_mix_b': bias(),
        'mem_wq': nrm((DEPTH, D_MODEL, D_MODEL), d_in),
        'mem_wkv': nrm((DEPTH, D_MODEL, 2 * D_MODEL), d_in) * kv_col_scale,
        'mem_wo': nrm((DEPTH, D_MODEL, D_MODEL), d_in * BETA),
        'ln_mem_g': gain(),
        'ln_mem_b': bias(),
        'ffn2_w13': nrm((DEPTH, D_MODEL, 2 * D_FF), d_in * BETA),
        'ffn2_w2': nrm((DEPTH, D_FF, D_MODEL), D_FF ** -0.5 * BETA),
        'ln_ffn2_g': gain(),
        'ln_ffn2_b': bias(),
    }


def reference(x_prompt, x_sample, mem_prompt, mem_sample,
              ffn1_w13, ffn1_w2, ln_ffn1_g, ln_ffn1_b,
              w_in, diff_lambda, diff_subln_g, rel_bias,
              ssm_lam_re, ssm_lam_im, ssm_log_step, ssm_b_re, ssm_b_im, ssm_c_re, ssm_c_im,
              ssm_d, ssm_glu_w, ssm_glu_b,
              w_out, ln_mix_g, ln_mix_b,
              mem_wq, mem_wkv, mem_wo, ln_mem_g, ln_mem_b,
              ffn2_w13, ffn2_w2, ln_ffn2_g, ln_ffn2_b):
    params = dict(
        ffn1_w13=ffn1_w13, ffn1_w2=ffn1_w2, ln_ffn1_g=ln_ffn1_g, ln_ffn1_b=ln_ffn1_b,
        w_in=w_in, diff_lambda=diff_lambda, diff_subln_g=diff_subln_g, rel_bias=rel_bias,
        ssm_lam_re=ssm_lam_re, ssm_lam_im=ssm_lam_im, ssm_log_step=ssm_log_step,
        ssm_b_re=ssm_b_re, ssm_b_im=ssm_b_im, ssm_c_re=ssm_c_re, ssm_c_im=ssm_c_im,
        ssm_d=ssm_d, ssm_glu_w=ssm_glu_w, ssm_glu_b=ssm_glu_b,
        w_out=w_out, ln_mix_g=ln_mix_g, ln_mix_b=ln_mix_b,
        mem_wq=mem_wq, mem_wkv=mem_wkv, mem_wo=mem_wo, ln_mem_g=ln_mem_g, ln_mem_b=ln_mem_b,
        ffn2_w13=ffn2_w13, ffn2_w2=ffn2_w2, ln_ffn2_g=ln_ffn2_g, ln_ffn2_b=ln_ffn2_b,
    )
    y_prompt = encoder_trunk(x_prompt, mem_prompt, params)
    y_sample = encoder_trunk(x_sample, mem_sample, params)
    return (y_prompt, y_sample)
```

```cpp
#include <hip/hip_runtime.h>
#include <hip/hip_cooperative_groups.h>
#include <cstdint>
#include <cstdio>
namespace cg = cooperative_groups;

#define LAS __attribute__((address_space(3)))
typedef unsigned short bf16_t;
typedef short bf16x8 __attribute__((ext_vector_type(8)));
typedef short s16x4 __attribute__((ext_vector_type(4)));
typedef float f32x4 __attribute__((ext_vector_type(4)));
typedef float f32x2 __attribute__((ext_vector_type(2)));
typedef float f32x16 __attribute__((ext_vector_type(16)));
typedef unsigned u32x4 __attribute__((ext_vector_type(4)));
typedef unsigned u32x2 __attribute__((ext_vector_type(2)));
typedef __bf16 bf16x2_t __attribute__((ext_vector_type(2)));

constexpr int NTOK = 98304, NPROMPT = 32768;
constexpr float ALPHA = 1.189207115002721f;
constexpr float LOG2E = 1.4426950408889634f;
constexpr float QSCALE = 0.125f * LOG2E;
constexpr float MSCALE = 0.0625f * LOG2E;
constexpr float LN_EPS = 1e-5f;
constexpr int LDS_BYTES = 160 * 1024;
constexpr int NTHREADS = 512;

struct Params {
    const float* in[34];
    float* out;
    bf16_t *W13T, *W2T, *WinT, *GluT, *WoutT, *WqN, *WkvT, *WoT, *W13bT, *W2bT;
    bf16_t *memb, *kvm, *Wqk, *VWo, *Mcat, *Pcat;
    float *KT, *stats, *cs_in, *cs_f2, *cs_m, *btab, *TA, *TC;
    char *SB, *SC, *SA;
    unsigned* barw;
    unsigned* pcnt;
    int ph_lo, ph_hi;
};
enum { I_XP = 0, I_XS, I_MP, I_MS, I_F1W13, I_F1W2, I_G1, I_B1, I_WIN, I_DLAM, I_SUBG, I_RELB, I_LRE, I_LIM, I_LSTEP, I_BRE, I_BIM, I_CRE, I_CIM,
       I_SSMD, I_GLUW, I_GLUB, I_WOUT, I_G2, I_B2, I_WQ, I_WKV, I_WO, I_G3, I_B3, I_F2W13, I_F2W2, I_G4, I_B4 };

constexpr size_t MiB = 1u << 20;
#define BUF_XB(P)   ((bf16_t*)(P).SA)
#define BUF_H1(P)   ((bf16_t*)(P).SB)
#define BUF_Y1B(P)  ((bf16_t*)(P).out)
#define BUF_Q(P)    ((bf16_t*)(P).SB)
#define BUF_K(P)    ((bf16_t*)((P).SB + 96 * MiB))
#define BUF_VT(P)   ((bf16_t*)((P).SB + 192 * MiB))
#define BUF_ACAT(P) ((bf16_t*)((P).SB + 288 * MiB))
#define BUF_X(P)    ((float*)((P).SB + 432 * MiB))
#define BUF_CAT(P)  ((bf16_t*)(P).SA)
#define BUF_Z(P)    ((bf16_t*)(P).SB)
#define BUF_Y2(P)   ((float*)(P).SC)
#define BUF_Y2B(P)  ((bf16_t*)(P).SB)
#define BUF_PM(P)   ((bf16_t*)(P).SA)
#define BUF_Y3B(P)  ((bf16_t*)(P).SB)
#define BUF_H2(P)   ((bf16_t*)(P).SC)

__device__ __forceinline__ unsigned f2bf(float f) { unsigned u = __builtin_bit_cast(unsigned, f); return (u + 0x7fffu + ((u >> 16) & 1u)) >> 16; }
__device__ __forceinline__ unsigned pk2(float lo, float hi) { f32x2 v = {lo, hi}; bf16x2_t b = __builtin_convertvector(v, bf16x2_t); return __builtin_bit_cast(unsigned, b); }
__device__ __forceinline__ float bf2f(unsigned short b) { return __builtin_bit_cast(float, (unsigned)b << 16); }
__device__ __forceinline__ float bflo(unsigned w) { return __builtin_bit_cast(float, w << 16); }
__device__ __forceinline__ float bfhi(unsigned w) { return __builtin_bit_cast(float, w & 0xffff0000u); }
#define LDS_WAIT() asm volatile("s_waitcnt lgkmcnt(0)" ::: "memory")

__device__ __forceinline__ int seq_of_pm(int pm) { return pm < 128 ? (pm >> 5) : 4 + ((pm - 128) >> 4); }

namespace pg8 {
constexpr int BM = 256, BK = 64, HALF = 128, HTB = HALF * BK * 2, STAGE_BYTES = 8 * HTB, NXCD = 8, WGM = 4;
__device__ __forceinline__ int lds_byte(int r, int c) { const int st = (r >> 4) * 2 + (c >> 5), rr = r & 15, cc = c & 31, ob = rr * 64 + cc * 2; return st * 1024 + (ob ^ (((ob >> 9) & 1) << 5)); }
__device__ __forceinline__ void stage_rc(int b, int& R, int& C) { const int st = b / 1024, sb = b % 1024, swz = sb ^ (((sb >> 9) & 1) << 5); R = (st >> 1) * 16 + swz / 64; C = (st & 1) * 32 + (swz % 64) / 2; }
__device__ __forceinline__ int perm32(int rho) { const int n = rho >> 4, i = rho & 15; return 8 * (i >> 2) + 4 * n + (i & 3); }
struct Unit { int pm, pn, grp; };
}
enum { M_SWIGLU = 0, M_RESID, M_QKU, M_VT, M_KVMEM, M_WQK, M_VWO, M_SSM1, M_SSM3, M_GLU, M_SCORES };
struct GD {
    const char* A; const char* B;
    int lda, ldb;
    int a_s1, a_s2, b_s1, b_s2;
    int gdiv, bseq;
    int K, nM, nN, ngrp, mode, perm, stage;
};
__device__ __forceinline__ bool unit_next(const GD& g, int i, int G, int c, pg8::Unit& u) {
    using namespace pg8;
    const int per = g.nM * g.nN, nwg = per * g.ngrp;
    const long L = (long)i * G + c; if (L >= nwg) return false;
    int wgid = (int)L; { const int q = nwg / NXCD, r = nwg % NXCD, xcd = wgid % NXCD, off = wgid / NXCD; wgid = (xcd < r ? xcd * (q + 1) : r * (q + 1) + (xcd - r) * q) + off; }
    u.grp = wgid / per; const int w = wgid % per;
    const int nig = WGM * g.nN, gid = w / nig, fm = gid * WGM, gsz = (g.nM - fm) < WGM ? (g.nM - fm) : WGM;
    u.pm = fm + ((w % nig) % gsz); u.pn = (w % nig) / gsz; return true;
}
__device__ __forceinline__ const char* unit_a(const GD& g, const pg8::Unit& u) { return g.A + (long)(u.grp / g.gdiv) * g.a_s1 + (long)(u.grp % g.gdiv) * g.a_s2 + (long)u.pm * 256 * g.lda; }
__device__ __forceinline__ const char* unit_b(const GD& g, const pg8::Unit& u) { const int gb = g.bseq ? seq_of_pm(u.pm) : (u.grp / g.gdiv); return g.B + (long)gb * g.b_s1 + (long)(u.grp % g.gdiv) * g.b_s2 + (long)u.pn * 256 * g.ldb; }

__device__ __forceinline__ float silu_f(float a) { return a * __builtin_amdgcn_rcpf(1.f + __builtin_amdgcn_exp2f(-LOG2E * a)); }
__device__ __forceinline__ float sigm_f(float a) { return __builtin_amdgcn_rcpf(1.f + __builtin_amdgcn_exp2f(-LOG2E * a)); }
__device__ __forceinline__ float gelu_tanh(float y) { const float t = 0.7978845608028654f * (y + 0.044715f * y * y * y); const float e = __builtin_amdgcn_exp2f(2.f * LOG2E * t); const float th = 1.f - 2.f * __builtin_amdgcn_rcpf(e + 1.f); return 0.5f * y * (1.f + th); }
__device__ __forceinline__ void row_stat(const float* st, int row, float& mu, float& rs) { const f32x2 s = *(const f32x2*)(st + 2 * (size_t)row); mu = s.x * (1.f / 1024.f); const float var = s.y * (1.f / 1024.f) - mu * mu; rs = rsqrtf(fmaxf(var, 0.f) + LN_EPS); }

template <int MODE> __device__ __forceinline__ void perm_epi(const Params* Pk, f32x4 (&acc)[2][2][4][2], const pg8::Unit& u, int rbase, int cw) {
    asm volatile("" : "+s"(Pk)); const Params& P = *Pk;
    float mus[2][4], rss[2][4];
#pragma unroll
    for (int ai = 0; ai < 2; ++ai)
#pragma unroll
        for (int m = 0; m < 4; ++m) { mus[ai][m] = 0.f; rss[ai][m] = 1.f; if (MODE == M_QKU) row_stat(P.stats, rbase + ai * 128 + m * 16, mus[ai][m], rss[ai][m]); }
#pragma unroll
    for (int bj = 0; bj < 2; ++bj) {
        const int cc = bj * 128 + cw; const int col = u.pn * 256 + cc;
        float k1[8], k2[8];
#pragma unroll
        for (int e = 0; e < 8; ++e) { k1[e] = 0.f; k2[e] = 0.f; }
        if (MODE == M_QKU) {
#pragma unroll
            for (int e = 0; e < 8; ++e) { k1[e] = P.cs_in[col + e]; k2[e] = P.cs_in[2048 + col + e]; }
        } else if (MODE == M_VT) {
#pragma unroll
            for (int e = 0; e < 8; ++e) row_stat(P.stats, col + e, k1[e], k2[e]);
        } else if (MODE == M_SCORES) { const float* cs = P.cs_m + (size_t)seq_of_pm(u.pm) * 1024 + col;
#pragma unroll
            for (int e = 0; e < 8; ++e) { k1[e] = cs[e]; k2[e] = cs[20 * 1024 + e]; }
        } else if (MODE == M_WQK) {
#pragma unroll
            for (int e = 0; e < 8; ++e) k1[e] = P.in[I_G2][col + e] * MSCALE;
        } else if (MODE == M_GLU) {
#pragma unroll
            for (int e = 0; e < 8; ++e) k1[e] = P.in[I_GLUB][col + e];
        }
#pragma unroll
        for (int ai = 0; ai < 2; ++ai)
#pragma unroll
            for (int m = 0; m < 4; ++m) {
                const int row = rbase + ai * 128 + m * 16;
                float v[8];
#pragma unroll
                for (int n = 0; n < 2; ++n)
#pragma unroll
                    for (int r = 0; r < 4; ++r) v[n * 4 + r] = acc[ai][bj][m][n][r];
                bf16_t* dst;
                if (MODE == M_QKU) {
                    const float mu = mus[ai][m], rs = rss[ai][m];
#pragma unroll
                    for (int e = 0; e < 8; ++e) v[e] = rs * (v[e] - mu * k1[e]) + k2[e];
                    if (u.pn < 2) { dst = BUF_Q(P) + (size_t)row * 512 + col;
#pragma unroll
                        for (int e = 0; e < 8; ++e) v[e] *= QSCALE; }
                    else if (u.pn < 4) dst = BUF_K(P) + (size_t)row * 512 + (col - 512);
                    else { const int ch = col - 1024; dst = BUF_ACAT(P) + ((size_t)((ch >> 4) * 3072 + (row >> 5)) * 768 + (row & 31) * 16 + (ch & 15)); }
                } else if (MODE == M_VT) {
                    const float c1 = P.cs_in[1536 + row], c2 = P.cs_in[2048 + 1536 + row];
#pragma unroll
                    for (int e = 0; e < 8; ++e) v[e] = k2[e] * (v[e] - k1[e] * c1) + c2;
                    dst = BUF_VT(P) + (size_t)row * NTOK + col;
                } else if (MODE == M_SCORES) {
                    float mu, rs; row_stat(P.stats + 2 * (size_t)NTOK, row, mu, rs);
#pragma unroll
                    for (int e = 0; e < 8; ++e) v[e] = rs * (v[e] - mu * k1[e]) + k2[e];
                    dst = BUF_PM(P) + (size_t)row * 1024 + col;
                } else if (MODE == M_KVMEM) dst = P.kvm + (size_t)row * 2048 + col;
                else if (MODE == M_WQK) { dst = P.Wqk + (size_t)(u.grp >> 2) * 1048576 + (size_t)((u.grp & 3) * 256 + row) * 1024 + col;
#pragma unroll
                    for (int e = 0; e < 8; ++e) v[e] *= k1[e]; }
                else if (MODE == M_VWO) dst = P.VWo + (size_t)(u.grp >> 2) * 1048576 + (size_t)row * 1024 + (u.grp & 3) * 256 + col;
                else if (MODE == M_SSM3) { dst = BUF_Z(P) + (size_t)(row * 32 + (col >> 4)) * 512 + u.grp * 16 + (col & 15);
#pragma unroll
                    for (int e = 0; e < 8; ++e) v[e] = gelu_tanh(v[e]); }
                else { const u32x4 zv = *(const u32x4*)(BUF_Z(P) + (size_t)row * 512 + col); dst = BUF_CAT(P) + (size_t)row * 1024 + 512 + col;
                    v[0] = bflo(zv.x) * sigm_f(v[0] + k1[0]); v[1] = bfhi(zv.x) * sigm_f(v[1] + k1[1]); v[2] = bflo(zv.y) * sigm_f(v[2] + k1[2]); v[3] = bfhi(zv.y) * sigm_f(v[3] + k1[3]);
                    v[4] = bflo(zv.z) * sigm_f(v[4] + k1[4]); v[5] = bfhi(zv.z) * sigm_f(v[5] + k1[5]); v[6] = bflo(zv.w) * sigm_f(v[6] + k1[6]); v[7] = bfhi(zv.w) * sigm_f(v[7] + k1[7]); }
                u32x4 w; w.x = pk2(v[0], v[1]); w.y = pk2(v[2], v[3]); w.z = pk2(v[4], v[5]); w.w = pk2(v[6], v[7]);
                if (MODE == M_VT) {
                    bf16_t* g16 = BUF_VT(P) + (size_t)row * NTOK + (col & ~15); const int hi8 = (col >> 3) & 1;
                    *(u32x2*)(g16 + hi8 * 4) = (u32x2){w.x, w.y}; *(u32x2*)(g16 + 8 + hi8 * 4) = (u32x2){w.z, w.w};
                } else *(u32x4*)dst = w;
            }
    }
}
__device__ __forceinline__ void gemm_epilogue(const GD& g, const Params* Pk, f32x4 (&acc)[2][2][4][2], const pg8::Unit& u, int wr, int wc, int fr, int fq, LAS unsigned char* xs) {
#if defined(EPI_ONLY)
    const int mode = (g.mode == EPI_ONLY) ? EPI_ONLY : 99; const int stage = g.stage;
#elif defined(EPI_SKIP)
    const int mode = (g.mode == EPI_SKIP || g.mode == EPI_SKIP2) ? 99 : g.mode; const int stage = g.stage;
#else
    const int mode = g.mode, stage = g.stage;
#endif
    const int rbase = u.pm * 256 + wr * 64 + fr;
    const int cw = wc * 32 + 8 * fq;
    const int cwn = wc * 32 + 4 * fq;
    if (mode == M_SWIGLU) {
        asm volatile("" : "+s"(Pk)); const Params& P = *Pk;
        const bool fold = stage == 4;
        bf16_t* O = fold ? BUF_H2(P) : BUF_H1(P);
        const float* st = P.stats + 4 * (size_t)NTOK;
        const float* cs = P.cs_f2 + u.pn * 256 + cw;
        f32x4 c1a[2], c2a[2], c1b[2], c2b[2];
#pragma unroll
        for (int n = 0; n < 2; ++n) { if (fold) { c1a[n] = *(const f32x4*)(cs + 4 * n); c2a[n] = *(const f32x4*)(cs + 5632 + 4 * n); c1b[n] = *(const f32x4*)(cs + 128 + 4 * n); c2b[n] = *(const f32x4*)(cs + 5632 + 128 + 4 * n); }
            else { c1a[n] = c2a[n] = c1b[n] = c2b[n] = (f32x4){0.f, 0.f, 0.f, 0.f}; } }
        float mus[2][4], rss[2][4];
#pragma unroll
        for (int ai = 0; ai < 2; ++ai)
#pragma unroll
            for (int m = 0; m < 4; ++m) { mus[ai][m] = 0.f; rss[ai][m] = 1.f; if (fold) row_stat(st, rbase + ai * 128 + m * 16, mus[ai][m], rss[ai][m]); }
#pragma unroll
        for (int ai = 0; ai < 2; ++ai)
#pragma unroll
            for (int m = 0; m < 4; ++m) {
                const int row = rbase + ai * 128 + m * 16; const float mu = mus[ai][m], rs = rss[ai][m];
                unsigned w[4];
#pragma unroll
                for (int n = 0; n < 2; ++n) {
                    float hv[4];
#pragma unroll
                    for (int r = 0; r < 4; ++r) { float a = acc[ai][0][m][n][r], b = acc[ai][1][m][n][r];
                        if (fold) { a = rs * (a - mu * c1a[n][r]) + c2a[n][r]; b = rs * (b - mu * c1b[n][r]) + c2b[n][r]; }
                        hv[r] = silu_f(a) * b; }
                    w[2 * n] = pk2(hv[0], hv[1]); w[2 * n + 1] = pk2(hv[2], hv[3]); }
                *(u32x4*)(O + (size_t)row * 2816 + u.pn * 128 + cw) = (u32x4){w[0], w[1], w[2], w[3]};
            }
    } else if (mode == M_RESID) {
        asm volatile("" : "+s"(Pk)); const Params& P = *Pk;
        const float scale = (stage == 1 || stage == 4) ? 0.5f : 1.f;
        if (stage == 4) {
            const bf16_t* prevb = BUF_Y3B(P); const float* pst = P.stats + 4 * (size_t)NTOK; const float* pg = P.in[I_G3]; const float* pb = P.in[I_B3]; float* st4 = P.stats + 6 * (size_t)NTOK;
            f32x4 gv[2][2], bv[2][2];
#pragma unroll
            for (int bj = 0; bj < 2; ++bj)
#pragma unroll
                for (int n = 0; n < 2; ++n) { const int c0 = u.pn * 256 + bj * 128 + n * 16 + cwn; gv[bj][n] = *(const f32x4*)(pg + c0); bv[bj][n] = *(const f32x4*)(pb + c0); }
#pragma unroll
            for (int ai = 0; ai < 2; ++ai)
#pragma unroll
                for (int m = 0; m < 4; ++m) {
                    const int row = rbase + ai * 128 + m * 16; float mu, rs; row_stat(pst, row, mu, rs);
                    float s = 0.f, ss = 0.f;
#pragma unroll
                    for (int bj = 0; bj < 2; ++bj)
#pragma unroll
                        for (int n = 0; n < 2; ++n) { const int c0 = u.pn * 256 + bj * 128 + n * 16 + cwn; const size_t off = (size_t)row * 1024 + c0;
                            const u32x2 w = *(const u32x2*)(prevb + off); f32x4 xp = (f32x4){bflo(w.x), bfhi(w.x), bflo(w.y), bfhi(w.y)};
                            xp = (xp - mu) * rs * gv[bj][n] + bv[bj][n];
                            const f32x4 y = xp * ALPHA + acc[ai][bj][m][n] * 0.5f; acc[ai][bj][m][n] = y;
                            s += (y[0] + y[1]) + (y[2] + y[3]); ss += (y[0] * y[0] + y[1] * y[1]) + (y[2] * y[2] + y[3] * y[3]); }
                    s += __shfl_xor(s, 16); s += __shfl_xor(s, 32); ss += __shfl_xor(ss, 16); ss += __shfl_xor(ss, 32);
                    if (fq == 0) { unsafeAtomicAdd(st4 + 2 * (size_t)row, s); unsafeAtomicAdd(st4 + 2 * (size_t)row + 1, ss); }
                }
            asm volatile("s_waitcnt vmcnt(0)" ::: "memory");
            unsigned* pc = P.pcnt + u.pm;
            if ((fr | fq) == 0) (void)__hip_atomic_fetch_add(pc, 1u, __ATOMIC_RELAXED, __HIP_MEMORY_SCOPE_AGENT);
            { unsigned sp = 0; while ((unsigned)__builtin_amdgcn_readfirstlane(__hip_atomic_load(pc, __ATOMIC_RELAXED, __HIP_MEMORY_SCOPE_AGENT)) < 32u) { __builtin_amdgcn_s_sleep(2); if (++sp > (1u << 22)) break; } }
            asm volatile("" ::: "memory");
            float* yo = P.out; const float* g4 = P.in[I_G4]; const float* b4 = P.in[I_B4];
#pragma unroll
            for (int bj = 0; bj < 2; ++bj)
#pragma unroll
                for (int n = 0; n < 2; ++n) { const int c0 = u.pn * 256 + bj * 128 + n * 16 + cwn; gv[bj][n] = *(const f32x4*)(g4 + c0); bv[bj][n] = *(const f32x4*)(b4 + c0); }
#pragma unroll
            for (int ai = 0; ai < 2; ++ai)
#pragma unroll
                for (int m = 0; m < 4; ++m) {
                    const int row = rbase + ai * 128 + m * 16;
                    const float sm = __hip_atomic_load(st4 + 2 * (size_t)row, __ATOMIC_RELAXED, __HIP_MEMORY_SCOPE_AGENT), sq = __hip_atomic_load(st4 + 2 * (size_t)row + 1, __ATOMIC_RELAXED, __HIP_MEMORY_SCOPE_AGENT);
                    const float mu = sm * (1.f / 1024.f); const float rs = rsqrtf(fmaxf(sq * (1.f / 1024.f) - mu * mu, 0.f) + LN_EPS);
#pragma unroll
                    for (int bj = 0; bj < 2; ++bj)
#pragma unroll
                        for (int n = 0; n < 2; ++n) { const int c0 = u.pn * 256 + bj * 128 + n * 16 + cwn;
                            *(f32x4*)(yo + (size_t)row * 1024 + c0) = (acc[ai][bj][m][n] - mu) * rs * gv[bj][n] + bv[bj][n]; }
                }
        } else {
        const float* prevf = nullptr; const bf16_t* prevb = nullptr; const float* pst = nullptr; const float* pg = nullptr; const float* pb = nullptr; float* yo = nullptr; bf16_t* yb = nullptr; float* ost = nullptr;
        if (stage == 1) { prevf = (u.pm < 128) ? P.in[I_XP] : (P.in[I_XS] - (size_t)NPROMPT * 1024); yb = BUF_Y1B(P); ost = P.stats; }
        else if (stage == 2) { prevb = BUF_Y1B(P); pst = P.stats; pg = P.in[I_G1]; pb = P.in[I_B1]; yb = BUF_Y2B(P); ost = P.stats + 2 * (size_t)NTOK; }
        else if (stage == 3) { prevb = BUF_Y2B(P); pst = P.stats + 2 * (size_t)NTOK; pg = P.in[I_G2]; pb = P.in[I_B2]; yb = BUF_Y3B(P); ost = P.stats + 4 * (size_t)NTOK; }
        else { prevb = BUF_Y3B(P); pst = P.stats + 4 * (size_t)NTOK; pg = P.in[I_G3]; pb = P.in[I_B3]; yo = P.out; }
        f32x4 gv[2][2], bv[2][2];
#pragma unroll
        for (int bj = 0; bj < 2; ++bj)
#pragma unroll
            for (int n = 0; n < 2; ++n) { const int c0 = u.pn * 256 + bj * 128 + n * 16 + cwn; if (pg) { gv[bj][n] = *(const f32x4*)(pg + c0); bv[bj][n] = *(const f32x4*)(pb + c0); } else { gv[bj][n] = (f32x4){1.f, 1.f, 1.f, 1.f}; bv[bj][n] = (f32x4){0.f, 0.f, 0.f, 0.f}; } }
#pragma unroll
        for (int ai = 0; ai < 2; ++ai) {
#pragma unroll
            for (int m = 0; m < 4; ++m) {
                const int row = rbase + ai * 128 + m * 16; float mu = 0.f, rs = 1.f; if (pst) row_stat(pst, row, mu, rs);
                float s = 0.f, ss = 0.f;
#pragma unroll
                for (int bj = 0; bj < 2; ++bj)
#pragma unroll
                    for (int n = 0; n < 2; ++n) { const int c0 = u.pn * 256 + bj * 128 + n * 16 + cwn; const size_t off = (size_t)row * 1024 + c0;
                        f32x4 xp;
                        if (prevf) xp = *(const f32x4*)(prevf + off);
                        else { const u32x2 w = *(const u32x2*)(prevb + off); xp = (f32x4){bflo(w.x), bfhi(w.x), bflo(w.y), bfhi(w.y)}; }
                        if (pg) xp = (xp - mu) * rs * gv[bj][n] + bv[bj][n];
                        const f32x4 y = xp * ALPHA + acc[ai][bj][m][n] * scale;
                        if (yo) *(f32x4*)(yo + off) = y;
                        if (yb) { u32x2 w; w.x = pk2(y[0], y[1]); w.y = pk2(y[2], y[3]); *(u32x2*)(yb + off) = w; }
                        s += (y[0] + y[1]) + (y[2] + y[3]); ss += (y[0] * y[0] + y[1] * y[1]) + (y[2] * y[2] + y[3] * y[3]); }
                if (ost) { s += __shfl_xor(s, 16); s += __shfl_xor(s, 32); ss += __shfl_xor(ss, 16); ss += __shfl_xor(ss, 32);
                    if (fq == 0) { unsafeAtomicAdd(ost + 2 * (size_t)row, s); unsafeAtomicAdd(ost + 2 * (size_t)row + 1, ss); } }
            }
        }
        }
    } else if (mode == M_SSM1) {
        asm volatile("" : "+s"(Pk)); const Params& P = *Pk;
        float* X = BUF_X(P) + (size_t)u.grp * 3072 * 256;
#pragma unroll
        for (int ai = 0; ai < 2; ++ai)
#pragma unroll
            for (int m = 0; m < 4; ++m) { const int row = rbase + ai * 128 + m * 16;
#pragma unroll
                for (int bj = 0; bj < 2; ++bj)
#pragma unroll
                    for (int n = 0; n < 2; ++n) *(f32x4*)(X + (size_t)row * 256 + bj * 128 + n * 16 + cwn) = acc[ai][bj][m][n]; }
    } else if (mode == M_QKU) perm_epi<M_QKU>(Pk, acc, u, rbase, cw);
    else if (mode == M_VT) perm_epi<M_VT>(Pk, acc, u, rbase, cw);
    else if (mode == M_KVMEM) perm_epi<M_KVMEM>(Pk, acc, u, rbase, cw);
    else if (mode == M_WQK) perm_epi<M_WQK>(Pk, acc, u, rbase, cw);
    else if (mode == M_VWO) perm_epi<M_VWO>(Pk, acc, u, rbase, cw);
    else if (mode == M_SSM3) perm_epi<M_SSM3>(Pk, acc, u, rbase, cw);
    else if (mode == M_GLU) perm_epi<M_GLU>(Pk, acc, u, rbase, cw);
    else if (mode == M_SCORES) {
        asm volatile("" : "+s"(Pk)); const Params& P = *Pk;
        const float* st = P.stats + 2 * (size_t)NTOK;
        const float* cs = P.cs_m + (size_t)seq_of_pm(u.pm) * 1024 + u.pn * 256 + cw;
        LAS f32x2* XS = (LAS f32x2*)xs;
        f32x4 k1[2][2], k2[2][2];
#pragma unroll
        for (int bj = 0; bj < 2; ++bj)
#pragma unroll
            for (int n = 0; n < 2; ++n) { k1[bj][n] = *(const f32x4*)(cs + bj * 128 + n * 4); k2[bj][n] = *(const f32x4*)(cs + 20 * 1024 + bj * 128 + n * 4); }
        float mw[2][4];
#pragma unroll
        for (int ai = 0; ai < 2; ++ai)
#pragma unroll
            for (int m = 0; m < 4; ++m) {
                const int row = rbase + ai * 128 + m * 16; float mu, rs; row_stat(st, row, mu, rs);
                float mx = -1e30f;
#pragma unroll
                for (int bj = 0; bj < 2; ++bj)
#pragma unroll
                    for (int n = 0; n < 2; ++n)
#pragma unroll
                        for (int r = 0; r < 4; ++r) { const float sv = rs * (acc[ai][bj][m][n][r] - mu * k1[bj][n][r]) + k2[bj][n][r]; acc[ai][bj][m][n][r] = sv; mx = fmaxf(mx, sv); }
                mx = fmaxf(mx, __shfl_xor(mx, 16)); mx = fmaxf(mx, __shfl_xor(mx, 32));
                float l = 0.f;
#pragma unroll
                for (int bj = 0; bj < 2; ++bj)
#pragma unroll
                    for (int n = 0; n < 2; ++n)
#pragma unroll
                        for (int r = 0; r < 4; ++r) { const float ev = __builtin_amdgcn_exp2f(acc[ai][bj][m][n][r] - mx); acc[ai][bj][m][n][r] = ev; l += ev; }
                l += __shfl_xor(l, 16); l += __shfl_xor(l, 32);
                mw[ai][m] = mx;
                if (fq == 0) XS[(ai * 128 + wr * 64 + m * 16 + fr) * 4 + wc] = (f32x2){mx, l};
            }
        LDS_WAIT(); __builtin_amdgcn_s_barrier(); asm volatile("" ::: "memory");
#pragma unroll
        for (int ai = 0; ai < 2; ++ai)
#pragma unroll
            for (int m = 0; m < 4; ++m) {
                const int rl = ai * 128 + wr * 64 + m * 16 + fr; const int row = u.pm * 256 + rl;
                const f32x2 a = XS[rl * 4 + 0], b = XS[rl * 4 + 1], c = XS[rl * 4 + 2], d = XS[rl * 4 + 3];
                const float M = fmaxf(fmaxf(a.x, b.x), fmaxf(c.x, d.x));
                const float Lt = a.y * __builtin_amdgcn_exp2f(a.x - M) + b.y * __builtin_amdgcn_exp2f(b.x - M) + c.y * __builtin_amdgcn_exp2f(c.x - M) + d.y * __builtin_amdgcn_exp2f(d.x - M);
                const float f = __builtin_amdgcn_exp2f(mw[ai][m] - M) * __builtin_amdgcn_rcpf(Lt);
#pragma unroll
                for (int bj = 0; bj < 2; ++bj) { const f32x4 v0 = acc[ai][bj][m][0] * f, v1 = acc[ai][bj][m][1] * f;
                    u32x4 w; w.x = pk2(v0[0], v0[1]); w.y = pk2(v0[2], v0[3]); w.z = pk2(v1[0], v1[1]); w.w = pk2(v1[2], v1[3]);
                    *(u32x4*)(BUF_PM(P) + (size_t)row * 1024 + u.pn * 256 + bj * 128 + cw) = w; }
            }
    }
}

__device__ __forceinline__ void gemm_phase(LAS unsigned char* lds, const GD& g, const Params& P, int G, int c, int tid) {
    using namespace pg8;
    const int wid = __builtin_amdgcn_readfirstlane(tid >> 6), lane = tid & 63, wr = wid >> 2, wc = wid & 3, fr = lane & 15, fq = lane >> 4;
    const int K = g.K, nt = K / BK;
    unsigned voffA, voffB;
    { int R, C; stage_rc(tid * 16, R, C); const int Rb = g.perm ? ((R & ~31) + perm32(R & 31)) : R;
        voffA = (unsigned)(R * g.lda + C * 2); voffB = (unsigned)(Rb * g.ldb + C * 2); }
    const int q64A = 64 * g.lda, q64B = 64 * g.ldb;
    const size_t kstep = (size_t)(BK * 2);
    const size_t hstepA = (size_t)HALF * g.lda, hstepB = (size_t)HALF * g.ldb;
    const unsigned ldsw = (unsigned)wid * 1024u;
    const int aoff = lds_byte(wr * 64 + fr, fq * 8), boff = lds_byte(wc * 32 + fr, fq * 8);
#define PG8_SA(b, h) (((b) * 2 + (h)) * HTB)
#define PG8_SB(b, h) ((4 + (b) * 2 + (h)) * HTB)
#define PG8_STAGE(bufoff, gbase, X) do { _Pragma("unroll") for (int _i = 0; _i < 2; ++_i) \
        __builtin_amdgcn_global_load_lds((const unsigned*)((const char*)(gbase) + (size_t)(_i * q64##X) + (voff##X)), (LAS unsigned*)(lds + (bufoff) + ldsw + _i * 8192), 16, 0, 0); } while (0)
#define PG8_LDA(dst, b, h) do { _Pragma("unroll") for (int m = 0; m < 4; ++m) _Pragma("unroll") for (int k = 0; k < 2; ++k) dst[m][k] = *(const LAS bf16x8*)(lds + PG8_SA(b, h) + aoff + m * 2048 + k * 1024); } while (0)
#define PG8_LDB(dst, b, h) do { _Pragma("unroll") for (int n = 0; n < 2; ++n) _Pragma("unroll") for (int k = 0; k < 2; ++k) dst[n][k] = *(const LAS bf16x8*)(lds + PG8_SB(b, h) + boff + n * 2048 + k * 1024); } while (0)
#define PG8_MMA(ai, bj, At, Bt) do { __builtin_amdgcn_s_setprio(1); _Pragma("unroll") for (int m = 0; m < 4; ++m) _Pragma("unroll") for (int n = 0; n < 2; ++n) _Pragma("unroll") for (int k = 0; k < 2; ++k) \
        acc[ai][bj][m][n] = __builtin_amdgcn_mfma_f32_16x16x32_bf16(Bt[n][k], At[m][k], acc[ai][bj][m][n], 0, 0, 0); __builtin_amdgcn_s_setprio(0); } while (0)
#define PG8_WAIT_V(n) asm volatile("s_waitcnt vmcnt(" #n ")" ::: "memory")
#define PG8_WAIT_L(n) asm volatile("s_waitcnt lgkmcnt(" #n ")" ::: "memory")
#define PG8_BAR __builtin_amdgcn_s_barrier()
#define PG8_SCHED __builtin_amdgcn_sched_barrier(0)
    LAS int* utab = (LAS int*)(lds + STAGE_BYTES + 8192);
    int nun;
    { const int nwg = g.nM * g.nN * g.ngrp; nun = (nwg > c) ? (nwg - 1 - c) / G + 1 : 0; if (nun > 63) nun = 63; }
    for (int i = tid; i < nun; i += NTHREADS) { Unit u; unit_next(g, i, G, c, u); const unsigned long long pa = (unsigned long long)unit_a(g, u), pb = (unsigned long long)unit_b(g, u);
        utab[i * 8 + 0] = (int)(unsigned)pa; utab[i * 8 + 1] = (int)(unsigned)(pa >> 32); utab[i * 8 + 2] = (int)(unsigned)pb; utab[i * 8 + 3] = (int)(unsigned)(pb >> 32); utab[i * 8 + 4] = u.pm; utab[i * 8 + 5] = u.pn; utab[i * 8 + 6] = u.grp; }
    __syncthreads();
    if (nun == 0) return;
#define UT(i, k) __builtin_amdgcn_readfirstlane(utab[(i) * 8 + (k)])
#define UPTR(i, k) ((const char*)(((unsigned long long)(unsigned)UT(i, k)) | ((unsigned long long)(unsigned)UT(i, (k) + 1) << 32)))
    Unit cur; int ui = 0;
    cur.pm = UT(0, 4); cur.pn = UT(0, 5); cur.grp = UT(0, 6);
    f32x4 acc[2][2][4][2];
#pragma unroll
    for (int a = 0; a < 2; ++a)
#pragma unroll
        for (int b = 0; b < 2; ++b)
#pragma unroll
            for (int m = 0; m < 4; ++m)
#pragma unroll
                for (int n = 0; n < 2; ++n) acc[a][b][m][n] = (f32x4){0.f, 0.f, 0.f, 0.f};
    bf16x8 At[4][2], B0[2][2], B1[2][2];
    const char* cA = UPTR(0, 0); const char* cB = UPTR(0, 2);
    PG8_STAGE(PG8_SB(0, 0), cB, B); PG8_STAGE(PG8_SB(0, 1), cB + hstepB, B); PG8_STAGE(PG8_SA(0, 0), cA, A); PG8_STAGE(PG8_SA(0, 1), cA + hstepA, A);
    if (wr == 1) PG8_BAR;
    PG8_WAIT_V(2); PG8_BAR;
    PG8_STAGE(PG8_SB(1, 0), cB + kstep, B); PG8_STAGE(PG8_SA(1, 0), cA + kstep, A); PG8_STAGE(PG8_SB(1, 1), cB + hstepB + kstep, B);
    PG8_WAIT_V(6); PG8_BAR;
    for (;;) {
        const bool has_next = (ui + 1 < nun);
        const char* nA = has_next ? UPTR(ui + 1, 0) : cA; const char* nB = has_next ? UPTR(ui + 1, 2) : cB;
        for (int t = 0; t < nt; t += 2) {
            const bool last = (t == nt - 2);
            const char* a1 = cA + (size_t)(t + 1) * kstep;
            const char* a2 = last ? nA : cA + (size_t)(t + 2) * kstep; const char* b2 = last ? nB : cB + (size_t)(t + 2) * kstep;
            const char* a3 = a2 + kstep; const char* b3 = b2 + kstep;
            PG8_LDB(B0, 0, 0); PG8_LDB(B1, 0, 1); PG8_SCHED; PG8_LDA(At, 0, 0); PG8_STAGE(PG8_SA(1, 1), a1 + hstepA, A);
            PG8_WAIT_V(8); PG8_WAIT_L(0); PG8_BAR; PG8_MMA(0, 0, At, B0); PG8_MMA(0, 1, At, B1); PG8_BAR; PG8_SCHED;
            PG8_LDA(At, 0, 1); PG8_STAGE(PG8_SB(0, 0), b2, B); PG8_STAGE(PG8_SB(0, 1), b2 + hstepB, B); PG8_STAGE(PG8_SA(0, 0), a2, A);
            PG8_WAIT_V(8); PG8_WAIT_L(0); PG8_BAR; PG8_MMA(1, 0, At, B0); PG8_MMA(1, 1, At, B1); PG8_BAR; PG8_SCHED;
            PG8_LDB(B0, 1, 0); PG8_LDB(B1, 1, 1); PG8_SCHED; PG8_LDA(At, 1, 0); PG8_STAGE(PG8_SA(0, 1), a2 + hstepA, A);
            PG8_WAIT_V(8); PG8_WAIT_L(0); PG8_BAR; PG8_MMA(0, 0, At, B0); PG8_MMA(0, 1, At, B1); PG8_BAR; PG8_SCHED;
            PG8_LDA(At, 1, 1); PG8_STAGE(PG8_SB(1, 0), b3, B); PG8_STAGE(PG8_SB(1, 1), b3 + hstepB, B); PG8_STAGE(PG8_SA(1, 0), a3, A);
            PG8_WAIT_V(8); PG8_WAIT_L(0); PG8_BAR; PG8_MMA(1, 0, At, B0); PG8_MMA(1, 1, At, B1); PG8_BAR; PG8_SCHED;
        }
        if (wr == 0) PG8_BAR;
        { const Params* Pk = (const Params*)__builtin_amdgcn_kernarg_segment_ptr(); asm volatile("" : "+s"(Pk));
          gemm_epilogue(g, Pk, acc, cur, wr, wc, fr, fq, lds + STAGE_BYTES); }
        if (!has_next) break;
#pragma unroll
        for (int a = 0; a < 2; ++a)
#pragma unroll
            for (int b = 0; b < 2; ++b)
#pragma unroll
                for (int m = 0; m < 4; ++m)
#pragma unroll
                    for (int n = 0; n < 2; ++n) acc[a][b][m][n] = (f32x4){0.f, 0.f, 0.f, 0.f};
        ++ui; cur.pm = UT(ui, 4); cur.pn = UT(ui, 5); cur.grp = UT(ui, 6); cA = nA; cB = nB;
        if (wr == 1) PG8_BAR;
    }
    PG8_WAIT_V(0);
    PG8_BAR;
#undef PG8_SA
#undef PG8_SB
#undef PG8_STAGE
#undef PG8_LDA
#undef PG8_LDB
#undef PG8_MMA
#undef PG8_WAIT_V
#undef PG8_WAIT_L
#undef PG8_BAR
#undef PG8_SCHED
#undef UT
#undef UPTR
}

__device__ __forceinline__ double reduce_2pi(double a) { return a - 6.283185307179586 * __builtin_rint(a * 0.15915494309189535); }
__device__ __forceinline__ f32x2 cpow_f(double lr, double li, int n) {
    const float mag = expf((float)((double)n * lr));
    const float ar = (float)reduce_2pi((double)n * li);
    return (f32x2){mag * cosf(ar), mag * sinf(ar)};
}
struct SsmC { double lr, li; float cre, cim; };
__device__ __forceinline__ SsmC ssm_consts(const Params& P, int dir, int g, int p) {
    const int idx = (dir * 32 + g) * 64 + p;
    const float lre = P.in[I_LRE][idx], lim = P.in[I_LIM][idx];
    const float step = expf(P.in[I_LSTEP][dir * 32 + g]);
    SsmC r; r.lr = (double)lre * (double)step; r.li = (double)lim * (double)step;
    const float yr = (float)reduce_2pi(r.li); const float s = sinf(yr), c = cosf(yr), s2 = sinf(0.5f * yr);
    const float em1 = expm1f((float)r.lr);
    const float are = em1 * c - 2.f * s2 * s2, aim = (em1 + 1.f) * s;
    const float den = 1.f / (lre * lre + lim * lim);
    r.cre = (are * lre + aim * lim) * den; r.cim = (aim * lre - are * lim) * den;
    return r;
}
__device__ __forceinline__ f32x2 cmul(f32x2 a, f32x2 b) { return (f32x2){a.x * b.x - a.y * b.y, a.x * b.y + a.y * b.x}; }

__device__ __forceinline__ int rel_bucket(int rel) {
    const int n = rel < 0 ? -rel : rel; int b;
    if (n < 8) b = n; else if (n < 12) b = 8; else if (n < 16) b = 9; else if (n < 23) b = 10; else if (n < 32) b = 11; else if (n < 46) b = 12; else if (n < 64) b = 13; else if (n < 91) b = 14; else b = 15;
    return b + (rel > 0 ? 16 : 0);
}

__device__ __forceinline__ void tr_item(const float* W, int K, int N, bf16_t* WT, int maptype, const float* gain, LAS float* scr, int item, int lane) {
    const int nblk = N / 32, kb = item / nblk, nb = item % nblk, k0 = 64 * kb, n0 = 32 * nb;
#pragma unroll 8
    for (int i = 0; i < 32; ++i) { const int kk = 2 * i + (lane >> 5); float v = W[(size_t)(k0 + kk) * N + n0 + (lane & 31)]; if (gain) v *= gain[k0 + kk]; scr[kk * 33 + (lane & 31)] = v; }
    LDS_WAIT();
    int o0 = n0;
    if (maptype == 1) o0 = (n0 < 2816) ? ((n0 / 128) * 256 + (n0 % 128)) : (((n0 - 2816) / 128) * 256 + 128 + ((n0 - 2816) % 128));
    else if (maptype == 2) o0 = (n0 < 1024) ? n0 : (n0 < 1536 ? 1536 + (n0 - 1024) : 1024 + (n0 - 1536));
    const int c = lane & 7;
#pragma unroll
    for (int j = 0; j < 4; ++j) { const int n = (lane >> 3) + 8 * j; const LAS float* s = scr + (8 * c) * 33 + n;
        u32x4 o; o.x = pk2(s[0 * 33], s[1 * 33]); o.y = pk2(s[2 * 33], s[3 * 33]); o.z = pk2(s[4 * 33], s[5 * 33]); o.w = pk2(s[6 * 33], s[7 * 33]);
        *(u32x4*)(WT + (size_t)(o0 + n) * K + k0 + 8 * c) = o; }
    LDS_WAIT();
}
__device__ __forceinline__ void cvt_range(const float* src, bf16_t* dst, size_t n4, size_t gt, size_t ngt) {
    for (size_t i = gt; i < n4; i += ngt) { const f32x4 v = *(const f32x4*)(src + 4 * i); u32x2 w; w.x = pk2(v[0], v[1]); w.y = pk2(v[2], v[3]); *(u32x2*)(dst + 4 * i) = w; }
}
__device__ __forceinline__ void prep_a(const Params& P, LAS unsigned char* lds, int vcu, int G, int tid) {
    const int lane = tid & 63, wave = tid >> 6;
    const int gw = vcu * 8 + wave, NGW = G * 8; const size_t gt = (size_t)vcu * NTHREADS + tid, ngt = (size_t)G * NTHREADS;
    LAS float* scr = (LAS float*)(lds + wave * 16384);
#pragma unroll 1
    for (int mi = 0; mi < 9; ++mi) {
        const Params* Pm = (const Params*)__builtin_amdgcn_kernarg_segment_ptr(); asm volatile("" : "+s"(Pm));
        const float* W; bf16_t* WT; int K = 1024, N = 1024, mt = 0; const float* gain = nullptr;
        switch (mi) {
        case 0: W = Pm->in[I_F1W13]; WT = Pm->W13T; N = 5632; mt = 1; break;
        case 1: W = Pm->in[I_F1W2]; WT = Pm->W2T; K = 2816; break;
        case 2: W = Pm->in[I_WIN]; WT = Pm->WinT; N = 2048; mt = 2; gain = Pm->in[I_G1]; break;
        case 3: W = Pm->in[I_GLUW]; WT = Pm->GluT; K = 512; N = 512; break;
        case 4: W = Pm->in[I_WOUT]; WT = Pm->WoutT; break;
        case 5: W = Pm->in[I_WKV]; WT = Pm->WkvT; N = 2048; break;
        case 6: W = Pm->in[I_WO]; WT = Pm->WoT; break;
        case 7: W = Pm->in[I_F2W13]; WT = Pm->W13bT; N = 5632; mt = 1; gain = Pm->in[I_G3]; break;
        default: W = Pm->in[I_F2W2]; WT = Pm->W2bT; K = 2816; break;
        }
        const int tot = (K / 64) * (N / 32);
        for (int it = gw; it < tot; it += NGW) tr_item(W, K, N, WT, mt, gain, scr, it, lane);
    }
    { const Params* Pm = (const Params*)__builtin_amdgcn_kernarg_segment_ptr(); asm volatile("" : "+s"(Pm)); }
    asm volatile("" ::: "memory");
    cvt_range(P.in[I_XP], BUF_XB(P), (size_t)NPROMPT * 256, gt, ngt);
    cvt_range(P.in[I_XS], BUF_XB(P) + (size_t)NPROMPT * 1024, (size_t)(NTOK - NPROMPT) * 256, gt, ngt);
    cvt_range(P.in[I_MP], P.memb, (size_t)4 * 256 * 256, gt, ngt);
    cvt_range(P.in[I_MS], P.memb + (size_t)4 * 256 * 1024, (size_t)16 * 256 * 256, gt, ngt);
    cvt_range(P.in[I_WQ], P.WqN, (size_t)1024 * 256, gt, ngt);
    for (size_t i = gt; i < (size_t)4 * NTOK * 2 / 4; i += ngt) *(f32x4*)(P.stats + 4 * i) = (f32x4){0.f, 0.f, 0.f, 0.f};
    for (size_t i = gt; i < 4 * 257; i += ngt) { const int h = (int)i / 257, idx = (int)i % 257; P.btab[h * 260 + idx] = P.in[I_RELB][rel_bucket(idx - 128) * 4 + h] * LOG2E; }
    for (size_t e = gt; e < (size_t)64 * 33 * 64; e += ngt) {
        const int p = (int)e & 63, n = (int)(e >> 6) % 33, dg = (int)(e >> 6) / 33;
        const SsmC sc = ssm_consts(P, dg >> 5, dg & 31, p);
        *(f32x2*)(P.TA + 2 * e) = cpow_f(sc.lr, sc.li, n);
        if (n == 0) *(f32x2*)(P.TC + 2 * (size_t)(dg * 64 + p)) = (f32x2){sc.cre, sc.cim};
    }
}
__device__ __forceinline__ void colsum_rows(const bf16_t* Wt, int nrows, const float* gam, const float* bet, float* cs1, float* cs2, int gw, int NGW, int lane) {
    float r[16];
#pragma unroll
    for (int e = 0; e < 16; ++e) r[e] = bet[lane * 16 + e] / gam[lane * 16 + e];
    for (int n = gw; n < nrows; n += NGW) {
        const u32x4 a = *(const u32x4*)(Wt + (size_t)n * 1024 + lane * 16), b = *(const u32x4*)(Wt + (size_t)n * 1024 + lane * 16 + 8);
        const float v[16] = {bflo(a.x), bfhi(a.x), bflo(a.y), bfhi(a.y), bflo(a.z), bfhi(a.z), bflo(a.w), bfhi(a.w), bflo(b.x), bfhi(b.x), bflo(b.y), bfhi(b.y), bflo(b.z), bfhi(b.z), bflo(b.w), bfhi(b.w)};
        float s1 = 0.f, s2 = 0.f;
#pragma unroll
        for (int e = 0; e < 16; ++e) { s1 += v[e]; s2 += v[e] * r[e]; }
#pragma unroll
        for (int o = 1; o < 64; o <<= 1) { s1 += __shfl_xor(s1, o); s2 += __shfl_xor(s2, o); }
        if (lane == 0) { cs1[n] = s1; cs2[n] = s2; }
    }
}
__device__ __forceinline__ void prep_b(const Params& P, int vcu, int G, int tid) {
    const int lane = tid & 63, wave = tid >> 6;
    const int gw = vcu * 8 + wave, NGW = G * 8; const size_t gt = (size_t)vcu * NTHREADS + tid, ngt = (size_t)G * NTHREADS;
    colsum_rows(P.WinT, 2048, P.in[I_G1], P.in[I_B1], P.cs_in, P.cs_in + 2048, gw, NGW, lane);
    colsum_rows(P.W13bT, 5632, P.in[I_G3], P.in[I_B3], P.cs_f2, P.cs_f2 + 5632, gw, NGW, lane);
    for (size_t e = gt; e < (size_t)32 * 2 * 32 * 256; e += ngt) {
        const int g = (int)(e >> 14), dir = (int)(e >> 13) & 1, tau = (int)(e >> 8) & 31, i = (int)(e >> 4) & 15, j = (int)e & 15;
        const int dg = dir * 32 + g; const f32x2* ta = (const f32x2*)P.TA + (size_t)(dg * 33 + tau) * 64; const f32x2* tc = (const f32x2*)P.TC + dg * 64;
        float sum = 0.f;
        for (int p = 0; p < 64; ++p) {
            const int idx = dg * 64 + p; const f32x2 B = {P.in[I_BRE][idx * 16 + j], P.in[I_BIM][idx * 16 + j]};
            const int ci = (dg * 16 + i) * 64 + p; const f32x2 C = {P.in[I_CRE][ci], P.in[I_CIM][ci]};
            sum += cmul(cmul(C, tc[p]), cmul(B, ta[p])).x;
        }
        P.KT[e] = sum;
    }
    for (size_t e = gt; e < (size_t)32 * 256 * 512; e += ngt) {
        const int g = (int)(e / (256 * 512)), row = (int)((e / 512) % 256), k = (int)(e % 512), s = k >> 4, j = k & 15, which = row >> 6, p = row & 63, dir = which >> 1;
        const int n = dir == 0 ? 31 - s : s; const int dg = dir * 32 + g;
        const f32x2 ap = ((const f32x2*)P.TA)[(size_t)(dg * 33 + n) * 64 + p], co = ((const f32x2*)P.TC)[dg * 64 + p];
        const int idx = dg * 64 + p; const f32x2 B = {P.in[I_BRE][idx * 16 + j], P.in[I_BIM][idx * 16 + j]};
        const f32x2 z = cmul(ap, cmul(co, B));
        P.Pcat[e] = (bf16_t)f2bf((which & 1) ? z.y : z.x);
    }
}
__device__ __forceinline__ void mcat_fill(const Params& P, int vcu, int G, int tid) {
    const size_t gt = (size_t)vcu * NTHREADS + tid, ngt = (size_t)G * NTHREADS;
    for (size_t e = gt; e < (size_t)32 * 512 * 768; e += ngt) {
        const int g = (int)(e / (512 * 768)), r = (int)((e / 768) % 512), col = (int)(e % 768), t = r >> 4, i = r & 15;
        float val;
        if (col < 512) { const int s = col >> 4, j = col & 15; val = 0.f;
            if (s <= t) val += P.KT[((size_t)(g * 2 + 0) * 32 + (t - s)) * 256 + i * 16 + j];
            if (s >= t) val += P.KT[((size_t)(g * 2 + 1) * 32 + (s - t)) * 256 + i * 16 + j];
            if (s == t && i == j) val += P.in[I_SSMD][g * 16 + i];
        } else { const int pp = col - 512, which = pp >> 6, p = pp & 63, dir = which >> 1; const int n = dir == 0 ? t + 1 : 32 - t; const int dg = dir * 32 + g;
            const f32x2 ap = ((const f32x2*)P.TA)[(size_t)(dg * 33 + n) * 64 + p];
            const int ci = (dg * 16 + i) * 64 + p; const f32x2 z = cmul((f32x2){P.in[I_CRE][ci], P.in[I_CIM][ci]}, ap);
            val = (which & 1) ? -z.y : z.x; }
        P.Mcat[e] = (bf16_t)f2bf(val);
    }
}

__device__ __forceinline__ void scan_phase(const Params& P, int vcu, int G, int tid) {
    const int lane = tid & 63, wave = tid >> 6; const int gw = vcu * 8 + wave, NGW = G * 8;
    for (int item = gw; item < 20 * 64; item += NGW) {
        const int seq = item >> 6, g = (item >> 1) & 31, dir = item & 1, p = lane;
        const int L = seq < 4 ? 8192 : 4096, tok0 = seq < 4 ? seq * 8192 : NPROMPT + (seq - 4) * 4096, nch = L / 32, cb = tok0 / 32;
        const f32x2 aT = ((const f32x2*)P.TA)[(size_t)((dir * 32 + g) * 33 + 32) * 64 + p];
        const float* X = BUF_X(P) + (size_t)g * 3072 * 256 + dir * 128 + p; bf16_t* Ac = BUF_ACAT(P) + (size_t)g * 3072 * 768 + 512 + dir * 128 + p;
        float sr = 0.f, si = 0.f;
        for (int c0 = 0; c0 < nch; c0 += 8) {
            float xr[8], xi[8];
#pragma unroll
            for (int k = 0; k < 8; ++k) { const int row = cb + (dir ? nch - 1 - (c0 + k) : c0 + k); xr[k] = X[(size_t)row * 256]; xi[k] = X[(size_t)row * 256 + 64]; }
#pragma unroll
            for (int k = 0; k < 8; ++k) { const int row = cb + (dir ? nch - 1 - (c0 + k) : c0 + k);
                Ac[(size_t)row * 768] = (bf16_t)f2bf(sr); Ac[(size_t)row * 768 + 64] = (bf16_t)f2bf(si);
                const float nr = aT.x * sr - aT.y * si + xr[k], ni = aT.x * si + aT.y * sr + xi[k]; sr = nr; si = ni; }
        }
    }
}

__device__ __forceinline__ int crow(int r, int hi) { return (r & 3) + 8 * (r >> 2) + 4 * hi; }
#define KSWZ(row, colB) ((row) * 256 + ((colB) ^ (((row) & 7) << 4)))
constexpr int AT_K = 0, AT_V = 49152, AT_VSZ = 16384, AT_WS = AT_V + 4 * AT_VSZ, AT_Q = AT_WS + 8 * 512, AT_BT = AT_Q + 32768;
static_assert(AT_BT + 260 * 4 <= LDS_BYTES, "attention LDS map");
#define MFMA32(a, b, c) __builtin_amdgcn_mfma_f32_32x32x16_bf16((a), (b), (c), 0, 0, 0)
#define GLDS16(gptr, ldsptr) __builtin_amdgcn_global_load_lds((const unsigned*)(gptr), (LAS unsigned*)(ldsptr), 16, 0, 0)
__device__ __forceinline__ bf16x8 pack8(const f32x16& p, int s) {
    u32x4 w; w.x = pk2(p[8 * s + 0], p[8 * s + 1]); w.y = pk2(p[8 * s + 2], p[8 * s + 3]); w.z = pk2(p[8 * s + 4], p[8 * s + 5]); w.w = pk2(p[8 * s + 6], p[8 * s + 7]);
    return __builtin_bit_cast(bf16x8, w);
}
__device__ __forceinline__ void tile_bias(int t, int qw, float btL, float btR, bool& nearb, float& cb) { const int kmin = t * 64; const bool fl = (kmin + 63 - qw <= -128), fr = (kmin - (qw + 31) >= 128); nearb = !(fl || fr); cb = fl ? btL : btR; }
__device__ __forceinline__ void attn_unit(const Params& P, LAS unsigned char* lds, int seq, int h, int qb, float lam, int tid_in) {
    int tid = tid_in; asm volatile("" : "+v"(tid));
    const int lane = tid & 63, r32 = lane & 31, hi = lane >> 5; const int wid = __builtin_amdgcn_readfirstlane(tid >> 6);
    const int qg = wid >> 1, m = wid & 1;
    const int L = seq < 4 ? 8192 : 4096, tok0 = seq < 4 ? seq * 8192 : NPROMPT + (seq - 4) * 4096, NT = L / 64;
    const int q0 = qb * 128, qw = q0 + qg * 32;
    LAS unsigned char* Ks = lds + AT_K; LAS unsigned char* Vs = lds + AT_V; LAS float* wsf = (LAS float*)(lds + AT_WS + wid * 512);
    LAS unsigned char* Qs = lds + AT_Q; LAS float* bt = (LAS float*)(lds + AT_BT);
    unsigned ko0, ko1, vo0, vo1;
    { int j = 2 * wid, row = 4 * j + (lane >> 4), lc = (lane & 15) ^ (row & 7); ko0 = (unsigned)(row * 512 + lc * 8) * 2u;
      j = 2 * wid + 1; row = 4 * j + (lane >> 4); lc = (lane & 15) ^ (row & 7); ko1 = (unsigned)(row * 512 + lc * 8) * 2u;
      j = 2 * wid; row = 8 * j + (lane >> 3); lc = (lane & 7) ^ ((row >> 1) & 7); vo0 = (unsigned)(row * NTOK + lc * 8) * 2u;
      j = 2 * wid + 1; row = 8 * j + (lane >> 3); lc = (lane & 7) ^ ((row >> 1) & 7); vo1 = (unsigned)(row * NTOK + lc * 8) * 2u; }
    const char* kbase = (const char*)(BUF_K(P) + (size_t)tok0 * 512 + h * 128);
    const char* vbase = (const char*)(BUF_VT(P) + (size_t)(h * 128) * NTOK + tok0);
    const int pdst = wid * 2048;
#define ATT_DMA(t, koff_, voff_) do { const char* kb_ = kbase + (size_t)(t) * (64 * 512 * 2); const char* vb_ = vbase + (size_t)(t) * 128; \
                             GLDS16(kb_ + ko0, Ks + (koff_) + pdst); GLDS16(kb_ + ko1, Ks + (koff_) + pdst + 1024); \
                             GLDS16(vb_ + vo0, Vs + (voff_) + pdst); GLDS16(vb_ + vo1, Vs + (voff_) + pdst + 1024); } while (0)
    ATT_DMA(0, 0, 0); ATT_DMA(1, 16384, AT_VSZ); ATT_DMA(2, 32768, 2 * AT_VSZ);
    for (int i = tid; i < 257; i += NTHREADS) bt[i] = P.btab[h * 260 + i];
#pragma unroll
    for (int i = 0; i < 4; ++i) { const int idx = tid + NTHREADS * i, row = idx >> 4, ch = idx & 15;
        const u32x4 v = *(const u32x4*)(BUF_Q(P) + (size_t)(tok0 + q0 + row) * 512 + h * 128 + ch * 8); *(LAS u32x4*)(Qs + KSWZ(row, ch * 16)) = v; }
    asm volatile("s_waitcnt vmcnt(0) lgkmcnt(0)" ::: "memory");
    __builtin_amdgcn_s_barrier(); asm volatile("" ::: "memory");
    f32x16 O[4];
#pragma unroll
    for (int d = 0; d < 4; ++d)
#pragma unroll
        for (int i = 0; i < 16; ++i) O[d][i] = 0.f;
    float mrun = 0.f, lsum = 0.f;
    const int qpos = qw + r32;
    const int vsw = (r32 >> 1) & 7;
    int vcur = 0, v1 = AT_VSZ, v2 = 2 * AT_VSZ, v3 = 3 * AT_VSZ; int k1 = 16384, k2 = 32768, k3 = 0;
    bf16x8 pa[4];
#define ATT_S(P0, P1, koff_, cinit_) do { _Pragma("unroll") for (int i = 0; i < 16; ++i) { P0[i] = (cinit_); P1[i] = (cinit_); } \
        _Pragma("unroll") for (int d0 = 0; d0 < 4; ++d0) { const int colB = (m * 64 + d0 * 16 + hi * 8) * 2; \
            const bf16x8 k0 = *(const LAS bf16x8*)(Ks + (koff_) + KSWZ(r32, colB)); const bf16x8 k1_ = *(const LAS bf16x8*)(Ks + (koff_) + KSWZ(32 + r32, colB)); \
            const bf16x8 qf = *(const LAS bf16x8*)(Qs + KSWZ(qg * 32 + r32, colB)); \
            P0 = MFMA32(k0, qf, P0); P1 = MFMA32(k1_, qf, P1); asm volatile("" ::: "memory"); } } while (0)
#define ATT_PV(voff_) do { _Pragma("unroll") for (int d0 = 0; d0 < 4; ++d0) _Pragma("unroll") for (int s = 0; s < 4; ++s) { const LAS unsigned char* vr = Vs + (voff_) + (32 * d0 + r32) * 128; \
        const bf16x8 vf = *(const LAS bf16x8*)(vr + (((2 * s + hi) ^ vsw) << 4));     \
        O[d0] = MFMA32(pa[s], vf, O[d0]); if (s == 3) asm volatile("" ::: "memory"); } } while (0)
#define ATT_STEP(t, PC0, PC1, PN0, PN1) do { \
        if ((t) + 3 < NT) ATT_DMA((t) + 3, k3, v3); \
        bool near_c; float cb_c; tile_bias((t), qw, btL, btR, near_c, cb_c); (void)cb_c; \
        if ((t) + 1 < NT) { const int t1_ = (t) + 1; const int kmin_n = t1_ * 64; const bool fl_n = (kmin_n + 63 - qw <= -128), fr_n = (kmin_n - (qw + 31) >= 128); \
            const float cin = ((fl_n || fr_n) ? (fl_n ? btL : btR) : 0.f) - mrun; ATT_S(PN0, PN1, k1, cin); } \
        if (near_c) { int qp_ = qpos, hn_ = hi; asm volatile("" : "+v"(qp_), "+v"(hn_)); const int kmin = (t) * 64; \
            _Pragma("unroll") for (int i = 0; i < 16; ++i) { const int rel = kmin + crow(i, hn_) - qp_; const int i0 = min(max(rel, -128), 128) + 128, i1 = min(max(rel + 32, -128), 128) + 128; PC0[i] += bt[i0]; PC1[i] += bt[i1]; if ((i & 3) == 3) asm volatile("" ::: "memory"); } } \
        float mx = fmaxf(fmaxf(PC0[0], PC1[0]), PC0[1]); \
        _Pragma("unroll") for (int i = 1; i < 15; i += 2) { mx = fmaxf(fmaxf(mx, PC1[i]), PC0[i + 1]); mx = fmaxf(fmaxf(mx, PC1[i + 1]), PC0[i + 2 < 16 ? i + 2 : 15]); } \
        mx = fmaxf(mx, PC1[15]); \
        { auto rr_ = __builtin_amdgcn_permlane32_swap(__float_as_uint(mx), __float_as_uint(mx), false, false); mx = fmaxf(__uint_as_float(rr_[0]), __uint_as_float(rr_[1])); }     \
        if ((t) == 0 || __any(mx > 4.f)) { \
            const float dl = ((t) == 0) ? mx : fmaxf(mx, 0.f); const float al = __builtin_amdgcn_exp2f(-dl); mrun += dl; \
            _Pragma("unroll") for (int i = 0; i < 16; ++i) { PC0[i] -= dl; PC1[i] -= dl; } \
            if ((t) + 1 < NT) { _Pragma("unroll") for (int i = 0; i < 16; ++i) { PN0[i] -= dl; PN1[i] -= dl; } } \
            if ((t) != 0) { lsum *= al; if (hi == 0) wsf[r32] = al; LDS_WAIT(); \
                _Pragma("unroll") for (int i = 0; i < 16; ++i) { const float a = wsf[crow(i, hi)]; _Pragma("unroll") for (int d = 0; d < 4; ++d) O[d][i] *= a; } } \
        } \
        float ps = 0.f; \
        _Pragma("unroll") for (int i = 0; i < 16; ++i) { PC0[i] = __builtin_amdgcn_exp2f(PC0[i]); PC1[i] = __builtin_amdgcn_exp2f(PC1[i]); ps += PC0[i] + PC1[i]; } \
        lsum += ps; \
        pa[0] = pack8(PC0, 0); pa[1] = pack8(PC0, 1); pa[2] = pack8(PC1, 0); pa[3] = pack8(PC1, 1); \
        ATT_PV(vcur); \
        if ((t) + 3 < NT) asm volatile("s_waitcnt vmcnt(4) lgkmcnt(0)" ::: "memory"); else asm volatile("s_waitcnt vmcnt(0) lgkmcnt(0)" ::: "memory"); \
        __builtin_amdgcn_s_barrier(); asm volatile("" ::: "memory"); \
        { const int tv = vcur; vcur = v1; v1 = v2; v2 = v3; v3 = tv; const int tk = k1; k1 = k2; k2 = k3; k3 = tk; } \
    } while (0)
    f32x16 pA0, pA1, pB0, pB1;
    const float btL = bt[0], btR = bt[256];
    { bool near0; float cb0; tile_bias(0, qw, btL, btR, near0, cb0); const float cin0 = near0 ? 0.f : cb0; ATT_S(pA0, pA1, 0, cin0); }
    asm volatile("s_waitcnt lgkmcnt(0)" ::: "memory"); __builtin_amdgcn_s_barrier(); asm volatile("" ::: "memory");
    for (int t = 0; t < NT; t += 2) {
        ATT_STEP(t, pA0, pA1, pB0, pB1);
        ATT_STEP(t + 1, pB0, pB1, pA0, pA1);
    }
    asm volatile("s_waitcnt lgkmcnt(0)" ::: "memory");
    __syncthreads();
#undef ATT_S
#undef ATT_STEP
#undef ATT_DMA
#undef ATT_PV
    int r32e = r32, hie = hi, lanee = lane; asm volatile("" : "+v"(r32e), "+v"(hie), "+v"(lanee));
    lsum += __shfl_xor(lsum, 32); if (hie == 0) wsf[r32e] = 1.f / lsum;
    LDS_WAIT();
    LAS float* xb = (LAS float*)(lds + AT_K) + qg * 4096 + lanee;
#pragma unroll
    for (int i = 0; i < 16; ++i) { const float il = wsf[crow(i, hie)];
#pragma unroll
        for (int d = 0; d < 4; ++d) O[d][i] *= il; }
    if (m == 1) {
#pragma unroll
        for (int d = 0; d < 4; ++d)
#pragma unroll
            for (int i = 0; i < 16; ++i) xb[(d * 16 + i) * 64] = O[d][i];
    }
    LDS_WAIT();
    __syncthreads();
    if (m == 0) {
        float ssq[16];
#pragma unroll
        for (int i = 0; i < 16; ++i) { float a = 0.f;
#pragma unroll
            for (int d = 0; d < 4; ++d) { const float v = O[d][i] - lam * xb[(d * 16 + i) * 64]; O[d][i] = v; a += v * v; }
            ssq[i] = a; }
#pragma unroll
        for (int i = 0; i < 16; ++i) {
#pragma unroll
            for (int o = 1; o < 32; o <<= 1) ssq[i] += __shfl_xor(ssq[i], o);
            ssq[i] = rsqrtf(ssq[i] * (1.f / 128.f) + 1e-5f); }
        bf16_t* outp = BUF_CAT(P) + (size_t)(tok0 + qw) * 1024 + h * 128 + r32e;
#pragma unroll
        for (int d = 0; d < 4; ++d) { const float gs = P.in[I_SUBG][32 * d + r32e] * 0.8f;
#pragma unroll
            for (int i = 0; i < 16; ++i) outp[(size_t)crow(i, hie) * 1024 + 32 * d] = (bf16_t)f2bf(O[d][i] * ssq[i] * gs); }
    }
    LDS_WAIT();
    __syncthreads();
}
__device__ __forceinline__ void attn_phase(const Params& P, LAS unsigned char* lds, int vcu, int G, int tid) {
    const int lane = tid & 63;
    float a = P.in[I_DLAM][lane] * P.in[I_DLAM][64 + lane], b = P.in[I_DLAM][128 + lane] * P.in[I_DLAM][192 + lane];
#pragma unroll
    for (int o = 1; o < 64; o <<= 1) { a += __shfl_xor(a, o); b += __shfl_xor(b, o); }
    const float lam = expf(a) - expf(b) + 0.2f;
    for (int u = vcu; u < 1024; u += G) attn_unit(P, lds, u >> 8, (u >> 6) & 3, u & 63, lam, tid);
    for (int u = vcu; u < 2048; u += G) attn_unit(P, lds, 4 + (u >> 7), (u >> 5) & 3, u & 31, lam, tid);
}

__device__ __forceinline__ void softmax_pass(const Params& P, int vcu, int G, int tid) {
    const int lane = tid & 63, wave = tid >> 6; const int gw = vcu * 8 + wave, NGW = G * 8;
    for (int row = gw; row < NTOK; row += NGW) {
        bf16_t* p = BUF_PM(P) + (size_t)row * 1024 + lane * 16;
        const u32x4 a = *(const u32x4*)p, b = *(const u32x4*)(p + 8);
        float v[16] = {bflo(a.x), bfhi(a.x), bflo(a.y), bfhi(a.y), bflo(a.z), bfhi(a.z), bflo(a.w), bfhi(a.w), bflo(b.x), bfhi(b.x), bflo(b.y), bfhi(b.y), bflo(b.z), bfhi(b.z), bflo(b.w), bfhi(b.w)};
        float mx = v[0];
#pragma unroll
        for (int e = 1; e < 16; ++e) mx = fmaxf(mx, v[e]);
#pragma unroll
        for (int o = 1; o < 16; o <<= 1) mx = fmaxf(mx, __shfl_xor(mx, o));
        float l = 0.f;
#pragma unroll
        for (int e = 0; e < 16; ++e) { v[e] = __builtin_amdgcn_exp2f(v[e] - mx); l += v[e]; }
#pragma unroll
        for (int o = 1; o < 16; o <<= 1) l += __shfl_xor(l, o);
        const float il = 1.f / l;
        u32x4 w0, w1; w0.x = pk2(v[0] * il, v[1] * il); w0.y = pk2(v[2] * il, v[3] * il); w0.z = pk2(v[4] * il, v[5] * il); w0.w = pk2(v[6] * il, v[7] * il);
        w1.x = pk2(v[8] * il, v[9] * il); w1.y = pk2(v[10] * il, v[11] * il); w1.z = pk2(v[12] * il, v[13] * il); w1.w = pk2(v[14] * il, v[15] * il);
        *(u32x4*)p = w0; *(u32x4*)(p + 8) = w1;
    }
}

__device__ __forceinline__ void final_ln(const Params& P, int vcu, int G, int tid) {
    const int lane = tid & 63, wave = tid >> 6; const int gw = vcu * 8 + wave, NGW = G * 8;
    f32x4 gv[4], bv[4];
#pragma unroll
    for (int j = 0; j < 4; ++j) { gv[j] = *(const f32x4*)(P.in[I_G4] + lane * 4 + 256 * j); bv[j] = *(const f32x4*)(P.in[I_B4] + lane * 4 + 256 * j); }
    for (int row = gw; row < NTOK; row += NGW) {
        float* xr = P.out + (size_t)row * 1024 + lane * 4; f32x4 v[4]; float s = 0.f;
#pragma unroll
        for (int j = 0; j < 4; ++j) { v[j] = *(const f32x4*)(xr + 256 * j); s += (v[j][0] + v[j][1]) + (v[j][2] + v[j][3]); }
#pragma unroll
        for (int o = 1; o < 64; o <<= 1) s += __shfl_xor(s, o);
        const float mean = s * (1.f / 1024.f); float q = 0.f;
#pragma unroll
        for (int j = 0; j < 4; ++j) { v[j] = v[j] - mean; q += (v[j][0] * v[j][0] + v[j][1] * v[j][1]) + (v[j][2] * v[j][2] + v[j][3] * v[j][3]); }
#pragma unroll
        for (int o = 1; o < 64; o <<= 1) q += __shfl_xor(q, o);
        const float rstd = rsqrtf(q * (1.f / 1024.f) + LN_EPS);
#pragma unroll
        for (int j = 0; j < 4; ++j) *(f32x4*)(xr + 256 * j) = v[j] * rstd * gv[j] + bv[j];
    }
}

__device__ __forceinline__ GD make_gd(const Params& P, int gi) {
    GD g; g.a_s1 = g.a_s2 = g.b_s1 = g.b_s2 = 0; g.gdiv = 1; g.bseq = 0; g.ngrp = 1; g.stage = 0; g.perm = 1; g.K = 1024; g.lda = g.ldb = 2048; g.nM = 384; g.nN = 4; g.mode = M_RESID; g.A = nullptr; g.B = nullptr;
    switch (gi) {
    case 0: g.A = (const char*)P.memb; g.B = (const char*)P.WkvT; g.nM = 20; g.nN = 8; g.mode = M_KVMEM; break;
    case 1: g.A = (const char*)BUF_XB(P); g.B = (const char*)P.W13T; g.nN = 22; g.mode = M_SWIGLU; g.stage = 1; break;
    case 2: g.A = (const char*)P.kvm; g.lda = 4096; g.a_s1 = 256 * 4096; g.a_s2 = 512; g.B = (const char*)P.WqN; g.b_s2 = 512; g.gdiv = 4; g.K = 256; g.nM = 1; g.nN = 4; g.ngrp = 80; g.mode = M_WQK; break;
    case 3: g.A = (const char*)P.WoT; g.a_s2 = 512; g.B = (const char*)P.kvm + 2048; g.ldb = 4096; g.b_s1 = 256 * 4096; g.b_s2 = 512; g.gdiv = 4; g.K = 256; g.nM = 4; g.nN = 1; g.ngrp = 80; g.mode = M_VWO; break;
    case 4: g.A = (const char*)BUF_H1(P); g.B = (const char*)P.W2T; g.lda = g.ldb = 5632; g.K = 2816; g.stage = 1; g.perm = 0; break;
    case 5: g.A = (const char*)BUF_Y1B(P); g.B = (const char*)P.WinT; g.nN = 6; g.mode = M_QKU; break;
    case 6: g.A = (const char*)(P.WinT + 1536 * 1024); g.B = (const char*)BUF_Y1B(P); g.nM = 2; g.nN = 384; g.mode = M_VT; break;
    case 7: g.A = (const char*)BUF_ACAT(P); g.lda = 1536; g.a_s1 = 3072 * 1536; g.B = (const char*)P.Pcat; g.ldb = 1024; g.b_s1 = 256 * 1024; g.K = 512; g.nM = 12; g.nN = 1; g.ngrp = 32; g.mode = M_SSM1; g.perm = 0; break;
    case 8: g.A = (const char*)BUF_ACAT(P); g.lda = 1536; g.a_s1 = 3072 * 1536; g.B = (const char*)P.Mcat; g.ldb = 1536; g.b_s1 = 512 * 1536; g.K = 768; g.nM = 12; g.nN = 2; g.ngrp = 32; g.mode = M_SSM3; break;
    case 9: g.A = (const char*)BUF_Z(P); g.B = (const char*)P.GluT; g.lda = g.ldb = 1024; g.K = 512; g.nN = 2; g.mode = M_GLU; break;
    case 10: g.A = (const char*)BUF_CAT(P); g.B = (const char*)P.WoutT; g.stage = 2; g.perm = 0; break;
    case 11: g.A = (const char*)BUF_Y2B(P); g.B = (const char*)P.Wqk; g.b_s1 = 1024 * 2048; g.bseq = 1; g.mode = M_SCORES; break;
    case 12: g.A = (const char*)BUF_PM(P); g.B = (const char*)P.VWo; g.b_s1 = 1024 * 2048; g.bseq = 1; g.stage = 3; g.perm = 0; break;
    case 13: g.A = (const char*)BUF_Y3B(P); g.B = (const char*)P.W13bT; g.nN = 22; g.mode = M_SWIGLU; g.stage = 4; break;
    default: g.A = (const char*)BUF_H2(P); g.B = (const char*)P.W2bT; g.lda = g.ldb = 5632; g.K = 2816; g.stage = 4; g.perm = 0; break;
    }
    return g;
}

#define XB_TMO      128
#define XB_XCNT(j)  (256  + 64 * (j))
#define XB_XSUB(j)  (1280 + 64 * (j))
#define XB_XGEN(j)  (2304 + 64 * (j))
#define XB_TOP      3328
#define XB_TOPGEN   3392
#define XCD_BAR_WORDS 3456
#define XB_SPIN_CAP (1u << 18)
__device__ __forceinline__ unsigned xb_ld(unsigned* p)              { return __hip_atomic_load(p, __ATOMIC_RELAXED, __HIP_MEMORY_SCOPE_AGENT); }
__device__ __forceinline__ unsigned xb_add(unsigned* p, unsigned v) { return __hip_atomic_fetch_add(p, v, __ATOMIC_RELAXED, __HIP_MEMORY_SCOPE_AGENT); }
__device__ __forceinline__ unsigned xb_xcc_id() { return (unsigned)__builtin_amdgcn_s_getreg((3 << 11) | 20) & 0xFu; }
#define XB_SPIN(cond, bar) do { unsigned _sp = 0; while (cond) { __builtin_amdgcn_s_sleep(1); \
    if ((++_sp & 255u) == 0u) { if (xb_ld(&(bar)[XB_TMO])) break; if (_sp > XB_SPIN_CAP) { atomicAdd(&(bar)[XB_TMO], 1u); break; } } } } while (0)
struct XcdBarrier { unsigned* bar; unsigned x; volatile LAS unsigned* st; };
__device__ __forceinline__ void xcd_barrier_complete(unsigned* bar, unsigned x, unsigned& nloc, unsigned& nx) {
    const unsigned G = gridDim.x * gridDim.y * gridDim.z;
    unsigned sum, cnt, mine, sp = 0u;
    for (;;) {
        sum = 0u; cnt = 0u; mine = 0u;
#pragma unroll
        for (unsigned j = 0; j < 16; ++j) { const unsigned c = xb_ld(&bar[XB_XCNT(j)]); sum += c; cnt += (c > 0u) ? 1u : 0u; mine = (j == x) ? c : mine; }
        if (sum == G) break;
        __builtin_amdgcn_s_sleep(1);
        if ((++sp & 255u) == 0u) { if (xb_ld(&bar[XB_TMO])) break; if (sp > XB_SPIN_CAP) { atomicAdd(&bar[XB_TMO], 1u); break; } }
    }
    nloc = mine > 0u ? mine : 1u; nx = cnt > 0u ? cnt : 1u;
}
__device__ __forceinline__ void xcd_barrier(unsigned* bar, volatile LAS unsigned* st) {
    asm volatile("s_waitcnt vmcnt(0)" ::: "memory");
    __syncthreads();
    if (threadIdx.x == 0) {
        const unsigned x = xb_xcc_id();
        __builtin_amdgcn_s_waitcnt(0);
        unsigned nloc = st[0], nx = st[1];
        if (nloc == 0u) { xcd_barrier_complete(bar, x, nloc, nx); st[0] = nloc; st[1] = nx; }
        const unsigned old = xb_add(&bar[XB_XSUB(x)], 1u);
        const unsigned gen = old / nloc;
        if (old + 1u == (gen + 1u) * nloc) {
            __builtin_amdgcn_fence(__ATOMIC_RELEASE, "agent");
            asm volatile("s_waitcnt vmcnt(0)" ::: "memory");
            const unsigned og = xb_add(&bar[XB_TOP], 1u);
            const unsigned tg = og / nx;
            if (og + 1u == (tg + 1u) * nx) xb_add(&bar[XB_TOPGEN], 1u);
            else XB_SPIN(xb_ld(&bar[XB_TOPGEN]) == tg, bar);
            __builtin_amdgcn_fence(__ATOMIC_ACQUIRE, "agent");
            xb_add(&bar[XB_XGEN(x)], 1u);
            asm volatile("s_waitcnt vmcnt(0)" ::: "memory");
        } else {
            XB_SPIN(xb_ld(&bar[XB_XGEN(x)]) == gen, bar);
            __builtin_amdgcn_fence(__ATOMIC_ACQUIRE, "agent");
            asm volatile("s_waitcnt vmcnt(0)" ::: "memory");
        }
    }
    __syncthreads();
}

template <int PH> __device__ __forceinline__ void run_phase(LAS unsigned char* lds, int vcu, int G, int bx) {
    const Params* Pk = (const Params*)__builtin_amdgcn_kernarg_segment_ptr(); asm volatile("" : "+s"(Pk));
    int tz = 0; asm volatile("" : "+v"(tz)); const int tid = (int)threadIdx.x + tz;
    const Params& Q = *Pk;
    constexpr int gfirst[14] = {0, 0, 2, 5, 7, 8, 8, 9, 10, 11, 12, 13, 14, 15};
    if constexpr (PH == 0) prep_a(Q, lds, vcu, G, tid);
    else if constexpr (PH == 1) prep_b(Q, vcu, G, tid);
    else if constexpr (PH == 2) mcat_fill(Q, vcu, G, tid);
    else if constexpr (PH == 3) colsum_rows(Q.Wqk, 20 * 1024, Q.in[I_G2], Q.in[I_B2], Q.cs_m, Q.cs_m + 20 * 1024, vcu * 8 + (tid >> 6), G * 8, tid & 63);
    else if constexpr (PH == 5) { scan_phase(Q, vcu, G, tid); attn_phase(Q, lds, vcu, G, tid); }
    if constexpr (gfirst[PH + 1] > gfirst[PH]) {
        __syncthreads();
#pragma unroll 1
        for (int gi = gfirst[PH]; gi < gfirst[PH + 1]; ++gi) { const GD g = make_gd(Q, gi); gemm_phase(lds, g, Q, G, bx, tid); }
    }
    if constexpr (PH == 0) cg::this_grid().sync();
    else if constexpr (PH < 12) xcd_barrier(Q.barw, (volatile LAS unsigned*)(lds + LDS_BYTES - 16));
}
__global__ void __launch_bounds__(NTHREADS, 2) mega_fwd(Params P) {
    extern __shared__ __attribute__((aligned(16))) unsigned char lds_raw[];
    LAS unsigned char* lds = (LAS unsigned char*)lds_raw;
    const int G = gridDim.x, bx = blockIdx.x;
    const int vcu = (G % 8 == 0) ? (bx % 8) * (G / 8) + bx / 8 : bx;
    if (threadIdx.x == 0) { volatile LAS unsigned* st = (volatile LAS unsigned*)(lds + LDS_BYTES - 16); st[0] = 0u; st[1] = 0u; (void)xb_add(&P.barw[XB_XCNT(xb_xcc_id())], 1u); }
    __syncthreads();
    run_phase<0>(lds, vcu, G, bx); run_phase<1>(lds, vcu, G, bx); run_phase<2>(lds, vcu, G, bx); run_phase<3>(lds, vcu, G, bx);
    run_phase<4>(lds, vcu, G, bx); run_phase<5>(lds, vcu, G, bx); run_phase<6>(lds, vcu, G, bx); run_phase<7>(lds, vcu, G, bx);
    run_phase<8>(lds, vcu, G, bx); run_phase<9>(lds, vcu, G, bx); run_phase<10>(lds, vcu, G, bx); run_phase<11>(lds, vcu, G, bx);
    run_phase<12>(lds, vcu, G, bx);
}

extern "C" void kernel_launch(void* const* d_in, const int* in_sizes, int n_in, void* d_out, int out_size, void* d_ws, size_t ws_size, hipStream_t stream) {
    static int grid = 0;
    if (grid == 0) {
        int dev = 0, cus = 0, per_cu = 0;
        (void)hipGetDevice(&dev); (void)hipDeviceGetAttribute(&cus, hipDeviceAttributeMultiprocessorCount, dev);
        (void)hipFuncSetAttribute((const void*)mega_fwd, hipFuncAttributeMaxDynamicSharedMemorySize, LDS_BYTES);
        (void)hipOccupancyMaxActiveBlocksPerMultiprocessor(&per_cu, (const void*)mega_fwd, NTHREADS, LDS_BYTES);
        if (per_cu < 1) per_cu = 1;
        grid = (cus > 0 ? cus : 256) * per_cu;
        if (ws_size < 976 * MiB) fprintf(stderr, "kernel_launch: workspace too small (%zu)\n", ws_size);
    }
    Params P{};
    for (int i = 0; i < 34; ++i) P.in[i] = (const float*)d_in[i];
    P.out = (float*)d_out;
    char* ws = (char*)d_ws; size_t off = 0;
    auto take = [&](size_t bytes) { char* p = ws + off; off += (bytes + 255) & ~(size_t)255; return p; };
    P.W13T = (bf16_t*)take(5632 * 1024 * 2); P.W2T = (bf16_t*)take(1024 * 2816 * 2); P.WinT = (bf16_t*)take(2048 * 1024 * 2); P.GluT = (bf16_t*)take(512 * 512 * 2);
    P.WoutT = (bf16_t*)take(1024 * 1024 * 2); P.WqN = (bf16_t*)take(1024 * 1024 * 2); P.WkvT = (bf16_t*)take(2048 * 1024 * 2); P.WoT = (bf16_t*)take(1024 * 1024 * 2);
    P.W13bT = (bf16_t*)take(5632 * 1024 * 2); P.W2bT = (bf16_t*)take(1024 * 2816 * 2);
    P.memb = (bf16_t*)take(5120 * 1024 * 2); P.kvm = (bf16_t*)take(5120 * 2048 * 2); P.Wqk = (bf16_t*)take((size_t)20 * 1024 * 1024 * 2); P.VWo = (bf16_t*)take((size_t)20 * 1024 * 1024 * 2);
    P.Mcat = (bf16_t*)take((size_t)32 * 512 * 768 * 2); P.Pcat = (bf16_t*)take((size_t)32 * 256 * 512 * 2);
    P.KT = (float*)take((size_t)32 * 2 * 32 * 256 * 4); P.stats = (float*)take((size_t)4 * NTOK * 2 * 4);
    P.cs_in = (float*)take(2 * 2048 * 4); P.cs_f2 = (float*)take(2 * 5632 * 4); P.cs_m = (float*)take(2 * 20 * 1024 * 4); P.btab = (float*)take(4 * 260 * 4); P.TA = (float*)take((size_t)64 * 33 * 64 * 8); P.TC = (float*)take((size_t)64 * 64 * 8); P.barw = (unsigned*)take(XCD_BAR_WORDS * 4 + 384 * 4); P.pcnt = P.barw + XCD_BAR_WORDS;
    P.SB = ws + 208 * MiB; P.SC = P.SB + 192 * MiB; P.SA = P.SC + 384 * MiB;
    P.ph_lo = 0; P.ph_hi = 16;
    (void)hipMemsetAsync(P.barw, 0, XCD_BAR_WORDS * 4 + 384 * 4, stream);
    void* args[] = {&P};
    hipError_t e = hipLaunchCooperativeKernel((const void*)mega_fwd, dim3(grid), dim3(NTHREADS), args, LDS_BYTES, stream);
    if (e != hipSuccess) fprintf(stderr, "cooperative launch failed: %s (grid %d)\n", hipGetErrorString(e), grid);
}
```

```cpp
#include <hip/hip_runtime.h>
#include <hip/hip_cooperative_groups.h>
#include <cstdint>
#include <cstdio>
namespace cg = cooperative_groups;

#define LAS __attribute__((address_space(3)))
typedef unsigned short bf16_t;
typedef short bf16x8 __attribute__((ext_vector_type(8)));
typedef short s16x4 __attribute__((ext_vector_type(4)));
typedef float f32x4 __attribute__((ext_vector_type(4)));
typedef float f32x2 __attribute__((ext_vector_type(2)));
typedef float f32x16 __attribute__((ext_vector_type(16)));
typedef unsigned u32x4 __attribute__((ext_vector_type(4)));
typedef unsigned u32x2 __attribute__((ext_vector_type(2)));
typedef __bf16 bf16x2_t __attribute__((ext_vector_type(2)));

constexpr int NTOK = 98304, NPROMPT = 32768;
constexpr float ALPHA = 1.189207115002721f;
constexpr float LOG2E = 1.4426950408889634f;
constexpr float QSCALE = 0.125f * LOG2E;
constexpr float MSCALE = 0.0625f * LOG2E;
constexpr float LN_EPS = 1e-5f;
constexpr int LDS_BYTES = 160 * 1024;
constexpr int NTHREADS = 512;

struct Params {
    const float* in[34];
    float* out;
    bf16_t *W13T, *W2T, *WinT, *GluT, *WoutT, *WqN, *WkvT, *WoT, *W13bT, *W2bT;
    bf16_t *memb, *kvm, *Wqk, *VWo, *Mcat, *Pcat;
    float *KT, *stats, *cs_in, *cs_f2, *cs_m, *btab, *TA, *TC;
    char *SB, *SC, *SA;
    unsigned* barw;
    unsigned* pcnt;
    int ph_lo, ph_hi;
};
enum { I_XP = 0, I_XS, I_MP, I_MS, I_F1W13, I_F1W2, I_G1, I_B1, I_WIN, I_DLAM, I_SUBG, I_RELB, I_LRE, I_LIM, I_LSTEP, I_BRE, I_BIM, I_CRE, I_CIM,
       I_SSMD, I_GLUW, I_GLUB, I_WOUT, I_G2, I_B2, I_WQ, I_WKV, I_WO, I_G3, I_B3, I_F2W13, I_F2W2, I_G4, I_B4 };

constexpr size_t MiB = 1u << 20;
#define BUF_XB(P)   ((bf16_t*)(P).SA)
#define BUF_H1(P)   ((bf16_t*)(P).SB)
#define BUF_Y1B(P)  ((bf16_t*)(P).out)
#define BUF_Q(P)    ((bf16_t*)(P).SB)
#define BUF_K(P)    ((bf16_t*)((P).SB + 96 * MiB))
#define BUF_VT(P)   ((bf16_t*)((P).SB + 192 * MiB))
#define BUF_ACAT(P) ((bf16_t*)((P).SB + 288 * MiB))
#define BUF_X(P)    ((float*)((P).SB + 432 * MiB))
#define BUF_CAT(P)  ((bf16_t*)(P).SA)
#define BUF_Z(P)    ((bf16_t*)(P).SB)
#define BUF_Y2(P)   ((float*)(P).SC)
#define BUF_Y2B(P)  ((bf16_t*)(P).SB)
#define BUF_PM(P)   ((bf16_t*)(P).SA)
#define BUF_Y3B(P)  ((bf16_t*)(P).SB)
#define BUF_H2(P)   ((bf16_t*)(P).SC)

__device__ __forceinline__ unsigned f2bf(float f) { unsigned u = __builtin_bit_cast(unsigned, f); return (u + 0x7fffu + ((u >> 16) & 1u)) >> 16; }
__device__ __forceinline__ unsigned pk2(float lo, float hi) { f32x2 v = {lo, hi}; bf16x2_t b = __builtin_convertvector(v, bf16x2_t); return __builtin_bit_cast(unsigned, b); }
__device__ __forceinline__ float bf2f(unsigned short b) { return __builtin_bit_cast(float, (unsigned)b << 16); }
__device__ __forceinline__ float bflo(unsigned w) { return __builtin_bit_cast(float, w << 16); }
__device__ __forceinline__ float bfhi(unsigned w) { return __builtin_bit_cast(float, w & 0xffff0000u); }
#define LDS_WAIT() asm volatile("s_waitcnt lgkmcnt(0)" ::: "memory")

__device__ __forceinline__ int seq_of_pm(int pm) { return pm < 128 ? (pm >> 5) : 4 + ((pm - 128) >> 4); }

namespace pg8 {
constexpr int BM = 256, BK = 64, HALF = 128, HTB = HALF * BK * 2, STAGE_BYTES = 8 * HTB, NXCD = 8, WGM = 4;
__device__ __forceinline__ int lds_byte(int r, int c) { const int st = (r >> 4) * 2 + (c >> 5), rr = r & 15, cc = c & 31, ob = rr * 64 + cc * 2; return st * 1024 + (ob ^ (((ob >> 9) & 1) << 5)); }
__device__ __forceinline__ void stage_rc(int b, int& R, int& C) { const int st = b / 1024, sb = b % 1024, swz = sb ^ (((sb >> 9) & 1) << 5); R = (st >> 1) * 16 + swz / 64; C = (st & 1) * 32 + (swz % 64) / 2; }
__device__ __forceinline__ int perm32(int rho) { const int n = rho >> 4, i = rho & 15; return 8 * (i >> 2) + 4 * n + (i & 3); }
struct Unit { int pm, pn, grp; };
}
enum { M_SWIGLU = 0, M_RESID, M_QKU, M_VT, M_KVMEM, M_WQK, M_VWO, M_SSM1, M_SSM3, M_GLU, M_SCORES };
struct GD {
    const char* A; const char* B;
    int lda, ldb;
    int a_s1, a_s2, b_s1, b_s2;
    int gdiv, bseq;
    int K, nM, nN, ngrp, mode, perm, stage;
};
__device__ __forceinline__ bool unit_next(const GD& g, int i, int G, int c, pg8::Unit& u) {
    using namespace pg8;
    const int per = g.nM * g.nN, nwg = per * g.ngrp;
    const long L = (long)i * G + c; if (L >= nwg) return false;
    int wgid = (int)L; { const int q = nwg / NXCD, r = nwg % NXCD, xcd = wgid % NXCD, off = wgid / NXCD; wgid = (xcd < r ? xcd * (q + 1) : r * (q + 1) + (xcd - r) * q) + off; }
    u.grp = wgid / per; const int w = wgid % per;
    const int nig = WGM * g.nN, gid = w / nig, fm = gid * WGM, gsz = (g.nM - fm) < WGM ? (g.nM - fm) : WGM;
    u.pm = fm + ((w % nig) % gsz); u.pn = (w % nig) / gsz; return true;
}
__device__ __forceinline__ const char* unit_a(const GD& g, const pg8::Unit& u) { return g.A + (long)(u.grp / g.gdiv) * g.a_s1 + (long)(u.grp % g.gdiv) * g.a_s2 + (long)u.pm * 256 * g.lda; }
__device__ __forceinline__ const char* unit_b(const GD& g, const pg8::Unit& u) { const int gb = g.bseq ? seq_of_pm(u.pm) : (u.grp / g.gdiv); return g.B + (long)gb * g.b_s1 + (long)(u.grp % g.gdiv) * g.b_s2 + (long)u.pn * 256 * g.ldb; }

__device__ __forceinline__ float silu_f(float a) { return a * __builtin_amdgcn_rcpf(1.f + __builtin_amdgcn_exp2f(-LOG2E * a)); }
__device__ __forceinline__ float sigm_f(float a) { return __builtin_amdgcn_rcpf(1.f + __builtin_amdgcn_exp2f(-LOG2E * a)); }
__device__ __forceinline__ float gelu_tanh(float y) { const float t = 0.7978845608028654f * (y + 0.044715f * y * y * y); const float e = __builtin_amdgcn_exp2f(2.f * LOG2E * t); const float th = 1.f - 2.f * __builtin_amdgcn_rcpf(e + 1.f); return 0.5f * y * (1.f + th); }
__device__ __forceinline__ void row_stat(const float* st, int row, float& mu, float& rs) { const f32x2 s = *(const f32x2*)(st + 2 * (size_t)row); mu = s.x * (1.f / 1024.f); const float var = s.y * (1.f / 1024.f) - mu * mu; rs = rsqrtf(fmaxf(var, 0.f) + LN_EPS); }

template <int MODE> __device__ __forceinline__ void perm_epi(const Params* Pk, f32x4 (&acc)[2][2][4][2], const pg8::Unit& u, int rbase, int cw) {
    asm volatile("" : "+s"(Pk)); const Params& P = *Pk;
    float mus[2][4], rss[2][4];
#pragma unroll
    for (int ai = 0; ai < 2; ++ai)
#pragma unroll
        for (int m = 0; m < 4; ++m) { mus[ai][m] = 0.f; rss[ai][m] = 1.f; if (MODE == M_QKU) row_stat(P.stats, rbase + ai * 128 + m * 16, mus[ai][m], rss[ai][m]); }
#pragma unroll
    for (int bj = 0; bj < 2; ++bj) {
        const int cc = bj * 128 + cw; const int col = u.pn * 256 + cc;
        float k1[8], k2[8];
#pragma unroll
        for (int e = 0; e < 8; ++e) { k1[e] = 0.f; k2[e] = 0.f; }
        if (MODE == M_QKU) {
#pragma unroll
            for (int e = 0; e < 8; ++e) { k1[e] = P.cs_in[col + e]; k2[e] = P.cs_in[2048 + col + e]; }
        } else if (MODE == M_VT) {
#pragma unroll
            for (int e = 0; e < 8; ++e) row_stat(P.stats, col + e, k1[e], k2[e]);
        } else if (MODE == M_SCORES) { const float* cs = P.cs_m + (size_t)seq_of_pm(u.pm) * 1024 + col;
#pragma unroll
            for (int e = 0; e < 8; ++e) { k1[e] = cs[e]; k2[e] = cs[20 * 1024 + e]; }
        } else if (MODE == M_WQK) {
#pragma unroll
            for (int e = 0; e < 8; ++e) k1[e] = P.in[I_G2][col + e] * MSCALE;
        } else if (MODE == M_GLU) {
#pragma unroll
            for (int e = 0; e < 8; ++e) k1[e] = P.in[I_GLUB][col + e];
        }
#pragma unroll
        for (int ai = 0; ai < 2; ++ai)
#pragma unroll
            for (int m = 0; m < 4; ++m) {
                const int row = rbase + ai * 128 + m * 16;
                float v[8];
#pragma unroll
                for (int n = 0; n < 2; ++n)
#pragma unroll
                    for (int r = 0; r < 4; ++r) v[n * 4 + r] = acc[ai][bj][m][n][r];
                bf16_t* dst;
                if (MODE == M_QKU) {
                    const float mu = mus[ai][m], rs = rss[ai][m];
#pragma unroll
                    for (int e = 0; e < 8; ++e) v[e] = rs * (v[e] - mu * k1[e]) + k2[e];
                    if (u.pn < 2) { dst = BUF_Q(P) + (size_t)row * 512 + col;
#pragma unroll
                        for (int e = 0; e < 8; ++e) v[e] *= QSCALE; }
                    else if (u.pn < 4) dst = BUF_K(P) + (size_t)row * 512 + (col - 512);
                    else { const int ch = col - 1024; dst = BUF_ACAT(P) + ((size_t)((ch >> 4) * 3072 + (row >> 5)) * 768 + (row & 31) * 16 + (ch & 15)); }
                } else if (MODE == M_VT) {
                    const float c1 = P.cs_in[1536 + row], c2 = P.cs_in[2048 + 1536 + row];
#pragma unroll
                    for (int e = 0; e < 8; ++e) v[e] = k2[e] * (v[e] - k1[e] * c1) + c2;
                    dst = BUF_VT(P) + (size_t)row * NTOK + col;
                } else if (MODE == M_SCORES) {
                    float mu, rs; row_stat(P.stats + 2 * (size_t)NTOK, row, mu, rs);
#pragma unroll
                    for (int e = 0; e < 8; ++e) v[e] = rs * (v[e] - mu * k1[e]) + k2[e];
                    dst = BUF_PM(P) + (size_t)row * 1024 + col;
                } else if (MODE == M_KVMEM) dst = P.kvm + (size_t)row * 2048 + col;
                else if (MODE == M_WQK) { dst = P.Wqk + (size_t)(u.grp >> 2) * 1048576 + (size_t)((u.grp & 3) * 256 + row) * 1024 + col;
#pragma unroll
                    for (int e = 0; e < 8; ++e) v[e] *= k1[e]; }
                else if (MODE == M_VWO) dst = P.VWo + (size_t)(u.grp >> 2) * 1048576 + (size_t)row * 1024 + (u.grp & 3) * 256 + col;
                else if (MODE == M_SSM3) { dst = BUF_Z(P) + (size_t)(row * 32 + (col >> 4)) * 512 + u.grp * 16 + (col & 15);
#pragma unroll
                    for (int e = 0; e < 8; ++e) v[e] = gelu_tanh(v[e]); }
                else { const u32x4 zv = *(const u32x4*)(BUF_Z(P) + (size_t)row * 512 + col); dst = BUF_CAT(P) + (size_t)row * 1024 + 512 + col;
                    v[0] = bflo(zv.x) * sigm_f(v[0] + k1[0]); v[1] = bfhi(zv.x) * sigm_f(v[1] + k1[1]); v[2] = bflo(zv.y) * sigm_f(v[2] + k1[2]); v[3] = bfhi(zv.y) * sigm_f(v[3] + k1[3]);
                    v[4] = bflo(zv.z) * sigm_f(v[4] + k1[4]); v[5] = bfhi(zv.z) * sigm_f(v[5] + k1[5]); v[6] = bflo(zv.w) * sigm_f(v[6] + k1[6]); v[7] = bfhi(zv.w) * sigm_f(v[7] + k1[7]); }
                u32x4 w; w.x = pk2(v[0], v[1]); w.y = pk2(v[2], v[3]); w.z = pk2(v[4], v[5]); w.w = pk2(v[6], v[7]);
                if (MODE == M_VT) {
                    bf16_t* g16 = BUF_VT(P) + (size_t)row * NTOK + (col & ~15); const int hi8 = (col >> 3) & 1;
                    *(u32x2*)(g16 + hi8 * 4) = (u32x2){w.x, w.y}; *(u32x2*)(g16 + 8 + hi8 * 4) = (u32x2){w.z, w.w};
                } else *(u32x4*)dst = w;
            }
    }
}
__device__ __forceinline__ void gemm_epilogue(const GD& g, const Params* Pk, f32x4 (&acc)[2][2][4][2], const pg8::Unit& u, int wr, int wc, int fr, int fq, LAS unsigned char* xs) {
#if defined(EPI_ONLY)
    const int mode = (g.mode == EPI_ONLY) ? EPI_ONLY : 99; const int stage = g.stage;
#elif defined(EPI_SKIP)
    const int mode = (g.mode == EPI_SKIP || g.mode == EPI_SKIP2) ? 99 : g.mode; const int stage = g.stage;
#else
    const int mode = g.mode, stage = g.stage;
#endif
    const int rbase = u.pm * 256 + wr * 64 + fr;
    const int cw = wc * 32 + 8 * fq;
    const int cwn = wc * 32 + 4 * fq;
    if (mode == M_SWIGLU) {
        asm volatile("" : "+s"(Pk)); const Params& P = *Pk;
        const bool fold = stage == 4;
        bf16_t* O = fold ? BUF_H2(P) : BUF_H1(P);
        const float* st = P.stats + 4 * (size_t)NTOK;
        const float* cs = P.cs_f2 + u.pn * 256 + cw;
        f32x4 c1a[2], c2a[2], c1b[2], c2b[2];
#pragma unroll
        for (int n = 0; n < 2; ++n) { if (fold) { c1a[n] = *(const f32x4*)(cs + 4 * n); c2a[n] = *(const f32x4*)(cs + 5632 + 4 * n); c1b[n] = *(const f32x4*)(cs + 128 + 4 * n); c2b[n] = *(const f32x4*)(cs + 5632 + 128 + 4 * n); }
            else { c1a[n] = c2a[n] = c1b[n] = c2b[n] = (f32x4){0.f, 0.f, 0.f, 0.f}; } }
        float mus[2][4], rss[2][4];
#pragma unroll
        for (int ai = 0; ai < 2; ++ai)
#pragma unroll
            for (int m = 0; m < 4; ++m) { mus[ai][m] = 0.f; rss[ai][m] = 1.f; if (fold) row_stat(st, rbase + ai * 128 + m * 16, mus[ai][m], rss[ai][m]); }
#pragma unroll
        for (int ai = 0; ai < 2; ++ai)
#pragma unroll
            for (int m = 0; m < 4; ++m) {
                const int row = rbase + ai * 128 + m * 16; const float mu = mus[ai][m], rs = rss[ai][m];
                unsigned w[4];
#pragma unroll
                for (int n = 0; n < 2; ++n) {
                    float hv[4];
#pragma unroll
                    for (int r = 0; r < 4; ++r) { float a = acc[ai][0][m][n][r], b = acc[ai][1][m][n][r];
                        if (fold) { a = rs * (a - mu * c1a[n][r]) + c2a[n][r]; b = rs * (b - mu * c1b[n][r]) + c2b[n][r]; }
                        hv[r] = silu_f(a) * b; }
                    w[2 * n] = pk2(hv[0], hv[1]); w[2 * n + 1] = pk2(hv[2], hv[3]); }
                *(u32x4*)(O + (size_t)row * 2816 + u.pn * 128 + cw) = (u32x4){w[0], w[1], w[2], w[3]};
            }
    } else if (mode == M_RESID) {
        asm volatile("" : "+s"(Pk)); const Params& P = *Pk;
        const float scale = (stage == 1 || stage == 4) ? 0.5f : 1.f;
        if (stage == 4) {
            const bf16_t* prevb = BUF_Y3B(P); const float* pst = P.stats + 4 * (size_t)NTOK; const float* pg = P.in[I_G3]; const float* pb = P.in[I_B3]; float* st4 = P.stats + 6 * (size_t)NTOK;
            f32x4 gv[2][2], bv[2][2];
#pragma unroll
            for (int bj = 0; bj < 2; ++bj)
#pragma unroll
                for (int n = 0; n < 2; ++n) { const int c0 = u.pn * 256 + bj * 128 + n * 16 + cwn; gv[bj][n] = *(const f32x4*)(pg + c0); bv[bj][n] = *(const f32x4*)(pb + c0); }
#pragma unroll
            for (int ai = 0; ai < 2; ++ai)
#pragma unroll
                for (int m = 0; m < 4; ++m) {
                    const int row = rbase + ai * 128 + m * 16; float mu, rs; row_stat(pst, row, mu, rs);
                    float s = 0.f, ss = 0.f;
#pragma unroll
                    for (int bj = 0; bj < 2; ++bj)
#pragma unroll
                        for (int n = 0; n < 2; ++n) { const int c0 = u.pn * 256 + bj * 128 + n * 16 + cwn; const size_t off = (size_t)row * 1024 + c0;
                            const u32x2 w = *(const u32x2*)(prevb + off); f32x4 xp = (f32x4){bflo(w.x), bfhi(w.x), bflo(w.y), bfhi(w.y)};
                            xp = (xp - mu) * rs * gv[bj][n] + bv[bj][n];
                            const f32x4 y = xp * ALPHA + acc[ai][bj][m][n] * 0.5f; acc[ai][bj][m][n] = y;
                            s += (y[0] + y[1]) + (y[2] + y[3]); ss += (y[0] * y[0] + y[1] * y[1]) + (y[2] * y[2] + y[3] * y[3]); }
                    s += __shfl_xor(s, 16); s += __shfl_xor(s, 32); ss += __shfl_xor(ss, 16); ss += __shfl_xor(ss, 32);
                    if (fq == 0) { unsafeAtomicAdd(st4 + 2 * (size_t)row, s); unsafeAtomicAdd(st4 + 2 * (size_t)row + 1, ss); }
                }
            asm volatile("s_waitcnt vmcnt(0)" ::: "memory");
            unsigned* pc = P.pcnt + u.pm;
            if ((fr | fq) == 0) (void)__hip_atomic_fetch_add(pc, 1u, __ATOMIC_RELAXED, __HIP_MEMORY_SCOPE_AGENT);
            { unsigned sp = 0; while ((unsigned)__builtin_amdgcn_readfirstlane(__hip_atomic_load(pc, __ATOMIC_RELAXED, __HIP_MEMORY_SCOPE_AGENT)) < 32u) { __builtin_amdgcn_s_sleep(2); if (++sp > (1u << 22)) break; } }
            asm volatile("" ::: "memory");
            float* yo = P.out; const float* g4 = P.in[I_G4]; const float* b4 = P.in[I_B4];
#pragma unroll
            for (int bj = 0; bj < 2; ++bj)
#pragma unroll
                for (int n = 0; n < 2; ++n) { const int c0 = u.pn * 256 + bj * 128 + n * 16 + cwn; gv[bj][n] = *(const f32x4*)(g4 + c0); bv[bj][n] = *(const f32x4*)(b4 + c0); }
#pragma unroll
            for (int ai = 0; ai < 2; ++ai)
#pragma unroll
                for (int m = 0; m < 4; ++m) {
                    const int row = rbase + ai * 128 + m * 16;
                    const float sm = __hip_atomic_load(st4 + 2 * (size_t)row, __ATOMIC_RELAXED, __HIP_MEMORY_SCOPE_AGENT), sq = __hip_atomic_load(st4 + 2 * (size_t)row + 1, __ATOMIC_RELAXED, __HIP_MEMORY_SCOPE_AGENT);
                    const float mu = sm * (1.f / 1024.f); const float rs = rsqrtf(fmaxf(sq * (1.f / 1024.f) - mu * mu, 0.f) + LN_EPS);
#pragma unroll
                    for (int bj = 0; bj < 2; ++bj)
#pragma unroll
                        for (int n = 0; n < 2; ++n) { const int c0 = u.pn * 256 + bj * 128 + n * 16 + cwn;
                            *(f32x4*)(yo + (size_t)row * 1024 + c0) = (acc[ai][bj][m][n] - mu) * rs * gv[bj][n] + bv[bj][n]; }
                }
        } else {
        const float* prevf = nullptr; const bf16_t* prevb = nullptr; const float* pst = nullptr; const float* pg = nullptr; const float* pb = nullptr; float* yo = nullptr; bf16_t* yb = nullptr; float* ost = nullptr;
        if (stage == 1) { prevf = (u.pm < 128) ? P.in[I_XP] : (P.in[I_XS] - (size_t)NPROMPT * 1024); yb = BUF_Y1B(P); ost = P.stats; }
        else if (stage == 2) { prevb = BUF_Y1B(P); pst = P.stats; pg = P.in[I_G1]; pb = P.in[I_B1]; yb = BUF_Y2B(P); ost = P.stats + 2 * (size_t)NTOK; }
        else if (stage == 3) { prevb = BUF_Y2B(P); pst = P.stats + 2 * (size_t)NTOK; pg = P.in[I_G2]; pb = P.in[I_B2]; yb = BUF_Y3B(P); ost = P.stats + 4 * (size_t)NTOK; }
        else { prevb = BUF_Y3B(P); pst = P.stats + 4 * (size_t)NTOK; pg = P.in[I_G3]; pb = P.in[I_B3]; yo = P.out; }
        f32x4 gv[2][2], bv[2][2];
#pragma unroll
        for (int bj = 0; bj < 2; ++bj)
#pragma unroll
            for (int n = 0; n < 2; ++n) { const int c0 = u.pn * 256 + bj * 128 + n * 16 + cwn; if (pg) { gv[bj][n] = *(const f32x4*)(pg + c0); bv[bj][n] = *(const f32x4*)(pb + c0); } else { gv[bj][n] = (f32x4){1.f, 1.f, 1.f, 1.f}; bv[bj][n] = (f32x4){0.f, 0.f, 0.f, 0.f}; } }
#pragma unroll
        for (int ai = 0; ai < 2; ++ai) {
#pragma unroll
            for (int m = 0; m < 4; ++m) {
                const int row = rbase + ai * 128 + m * 16; float mu = 0.f, rs = 1.f; if (pst) row_stat(pst, row, mu, rs);
                float s = 0.f, ss = 0.f;
#pragma unroll
                for (int bj = 0; bj < 2; ++bj)
#pragma unroll
                    for (int n = 0; n < 2; ++n) { const int c0 = u.pn * 256 + bj * 128 + n * 16 + cwn; const size_t off = (size_t)row * 1024 + c0;
                        f32x4 xp;
                        if (prevf) xp = *(const f32x4*)(prevf + off);
                        else { const u32x2 w = *(const u32x2*)(prevb + off); xp = (f32x4){bflo(w.x), bfhi(w.x), bflo(w.y), bfhi(w.y)}; }
                        if (pg) xp = (xp - mu) * rs * gv[bj][n] + bv[bj][n];
                        const f32x4 y = xp * ALPHA + acc[ai][bj][m][n] * scale;
                        if (yo) *(f32x4*)(yo + off) = y;
                        if (yb) { u32x2 w; w.x = pk2(y[0], y[1]); w.y = pk2(y[2], y[3]); *(u32x2*)(yb + off) = w; }
                        s += (y[0] + y[1]) + (y[2] + y[3]); ss += (y[0] * y[0] + y[1] * y[1]) + (y[2] * y[2] + y[3] * y[3]); }
                if (ost) { s += __shfl_xor(s, 16); s += __shfl_xor(s, 32); ss += __shfl_xor(ss, 16); ss += __shfl_xor(ss, 32);
                    if (fq == 0) { unsafeAtomicAdd(ost + 2 * (size_t)row, s); unsafeAtomicAdd(ost + 2 * (size_t)row + 1, ss); } }
            }
        }
        }
    } else if (mode == M_SSM1) {
        asm volatile("" : "+s"(Pk)); const Params& P = *Pk;
        float* X = BUF_X(P) + (size_t)u.grp * 3072 * 256;
#pragma unroll
        for (int ai = 0; ai < 2; ++ai)
#pragma unroll
            for (int m = 0; m < 4; ++m) { const int row = rbase + ai * 128 + m * 16;
#pragma unroll
                for (int bj = 0; bj < 2; ++bj)
#pragma unroll
                    for (int n = 0; n < 2; ++n) *(f32x4*)(X + (size_t)row * 256 + bj * 128 + n * 16 + cwn) = acc[ai][bj][m][n]; }
    } else if (mode == M_QKU) perm_epi<M_QKU>(Pk, acc, u, rbase, cw);
    else if (mode == M_VT) perm_epi<M_VT>(Pk, acc, u, rbase, cw);
    else if (mode == M_KVMEM) perm_epi<M_KVMEM>(Pk, acc, u, rbase, cw);
    else if (mode == M_WQK) perm_epi<M_WQK>(Pk, acc, u, rbase, cw);
    else if (mode == M_VWO) perm_epi<M_VWO>(Pk, acc, u, rbase, cw);
    else if (mode == M_SSM3) perm_epi<M_SSM3>(Pk, acc, u, rbase, cw);
    else if (mode == M_GLU) perm_epi<M_GLU>(Pk, acc, u, rbase, cw);
    else if (mode == M_SCORES) {
        asm volatile("" : "+s"(Pk)); const Params& P = *Pk;
        const float* st = P.stats + 2 * (size_t)NTOK;
        const float* cs = P.cs_m + (size_t)seq_of_pm(u.pm) * 1024 + u.pn * 256 + cw;
        LAS f32x2* XS = (LAS f32x2*)xs;
        f32x4 k1[2][2], k2[2][2];
#pragma unroll
        for (int bj = 0; bj < 2; ++bj)
#pragma unroll
            for (int n = 0; n < 2; ++n) { k1[bj][n] = *(const f32x4*)(cs + bj * 128 + n * 4); k2[bj][n] = *(const f32x4*)(cs + 20 * 1024 + bj * 128 + n * 4); }
        float mw[2][4];
#pragma unroll
        for (int ai = 0; ai < 2; ++ai)
#pragma unroll
            for (int m = 0; m < 4; ++m) {
                const int row = rbase + ai * 128 + m * 16; float mu, rs; row_stat(st, row, mu, rs);
                float mx = -1e30f;
#pragma unroll
                for (int bj = 0; bj < 2; ++bj)
#pragma unroll
                    for (int n = 0; n < 2; ++n)
#pragma unroll
                        for (int r = 0; r < 4; ++r) { const float sv = rs * (acc[ai][bj][m][n][r] - mu * k1[bj][n][r]) + k2[bj][n][r]; acc[ai][bj][m][n][r] = sv; mx = fmaxf(mx, sv); }
                mx = fmaxf(mx, __shfl_xor(mx, 16)); mx = fmaxf(mx, __shfl_xor(mx, 32));
                float l = 0.f;
#pragma unroll
                for (int bj = 0; bj < 2; ++bj)
#pragma unroll
                    for (int n = 0; n < 2; ++n)
#pragma unroll
                        for (int r = 0; r < 4; ++r) { const float ev = __builtin_amdgcn_exp2f(acc[ai][bj][m][n][r] - mx); acc[ai][bj][m][n][r] = ev; l += ev; }
                l += __shfl_xor(l, 16); l += __shfl_xor(l, 32);
                mw[ai][m] = mx;
                if (fq == 0) XS[(ai * 128 + wr * 64 + m * 16 + fr) * 4 + wc] = (f32x2){mx, l};
            }
        LDS_WAIT(); __builtin_amdgcn_s_barrier(); asm volatile("" ::: "memory");
#pragma unroll
        for (int ai = 0; ai < 2; ++ai)
#pragma unroll
            for (int m = 0; m < 4; ++m) {
                const int rl = ai * 128 + wr * 64 + m * 16 + fr; const int row = u.pm * 256 + rl;
                const f32x2 a = XS[rl * 4 + 0], b = XS[rl * 4 + 1], c = XS[rl * 4 + 2], d = XS[rl * 4 + 3];
                const float M = fmaxf(fmaxf(a.x, b.x), fmaxf(c.x, d.x));
                const float Lt = a.y * __builtin_amdgcn_exp2f(a.x - M) + b.y * __builtin_amdgcn_exp2f(b.x - M) + c.y * __builtin_amdgcn_exp2f(c.x - M) + d.y * __builtin_amdgcn_exp2f(d.x - M);
                const float f = __builtin_amdgcn_exp2f(mw[ai][m] - M) * __builtin_amdgcn_rcpf(Lt);
#pragma unroll
                for (int bj = 0; bj < 2; ++bj) { const f32x4 v0 = acc[ai][bj][m][0] * f, v1 = acc[ai][bj][m][1] * f;
                    u32x4 w; w.x = pk2(v0[0], v0[1]); w.y = pk2(v0[2], v0[3]); w.z = pk2(v1[0], v1[1]); w.w = pk2(v1[2], v1[3]);
                    *(u32x4*)(BUF_PM(P) + (size_t)row * 1024 + u.pn * 256 + bj * 128 + cw) = w; }
            }
    }
}

__device__ __forceinline__ void gemm_phase(LAS unsigned char* lds, const GD& g, const Params& P, int G, int c, int tid) {
    using namespace pg8;
    const int wid = __builtin_amdgcn_readfirstlane(tid >> 6), lane = tid & 63, wr = wid >> 2, wc = wid & 3, fr = lane & 15, fq = lane >> 4;
    const int K = g.K, nt = K / BK;
    unsigned voffA, voffB;
    { int R, C; stage_rc(tid * 16, R, C); const int Rb = g.perm ? ((R & ~31) + perm32(R & 31)) : R;
        voffA = (unsigned)(R * g.lda + C * 2); voffB = (unsigned)(Rb * g.ldb + C * 2); }
    const int q64A = 64 * g.lda, q64B = 64 * g.ldb;
    const size_t kstep = (size_t)(BK * 2);
    const size_t hstepA = (size_t)HALF * g.lda, hstepB = (size_t)HALF * g.ldb;
    const unsigned ldsw = (unsigned)wid * 1024u;
    const int aoff = lds_byte(wr * 64 + fr, fq * 8), boff = lds_byte(wc * 32 + fr, fq * 8);
#define PG8_SA(b, h) (((b) * 2 + (h)) * HTB)
#define PG8_SB(b, h) ((4 + (b) * 2 + (h)) * HTB)
#define PG8_STAGE(bufoff, gbase, X) do { _Pragma("unroll") for (int _i = 0; _i < 2; ++_i) \
        __builtin_amdgcn_global_load_lds((const unsigned*)((const char*)(gbase) + (size_t)(_i * q64##X) + (voff##X)), (LAS unsigned*)(lds + (bufoff) + ldsw + _i * 8192), 16, 0, 0); } while (0)
#define PG8_LDA(dst, b, h) do { _Pragma("unroll") for (int m = 0; m < 4; ++m) _Pragma("unroll") for (int k = 0; k < 2; ++k) dst[m][k] = *(const LAS bf16x8*)(lds + PG8_SA(b, h) + aoff + m * 2048 + k * 1024); } while (0)
#define PG8_LDB(dst, b, h) do { _Pragma("unroll") for (int n = 0; n < 2; ++n) _Pragma("unroll") for (int k = 0; k < 2; ++k) dst[n][k] = *(const LAS bf16x8*)(lds + PG8_SB(b, h) + boff + n * 2048 + k * 1024); } while (0)
#define PG8_MMA(ai, bj, At, Bt) do { __builtin_amdgcn_s_setprio(1); _Pragma("unroll") for (int m = 0; m < 4; ++m) _Pragma("unroll") for (int n = 0; n < 2; ++n) _Pragma("unroll") for (int k = 0; k < 2; ++k) \
        acc[ai][bj][m][n] = __builtin_amdgcn_mfma_f32_16x16x32_bf16(Bt[n][k], At[m][k], acc[ai][bj][m][n], 0, 0, 0); __builtin_amdgcn_s_setprio(0); } while (0)
#define PG8_WAIT_V(n) asm volatile("s_waitcnt vmcnt(" #n ")" ::: "memory")
#define PG8_WAIT_L(n) asm volatile("s_waitcnt lgkmcnt(" #n ")" ::: "memory")
#define PG8_BAR __builtin_amdgcn_s_barrier()
#define PG8_SCHED __builtin_amdgcn_sched_barrier(0)
    LAS int* utab = (LAS int*)(lds + STAGE_BYTES + 8192);
    int nun;
    { const int nwg = g.nM * g.nN * g.ngrp; nun = (nwg > c) ? (nwg - 1 - c) / G + 1 : 0; if (nun > 63) nun = 63; }
    for (int i = tid; i < nun; i += NTHREADS) { Unit u; unit_next(g, i, G, c, u); const unsigned long long pa = (unsigned long long)unit_a(g, u), pb = (unsigned long long)unit_b(g, u);
        utab[i * 8 + 0] = (int)(unsigned)pa; utab[i * 8 + 1] = (int)(unsigned)(pa >> 32); utab[i * 8 + 2] = (int)(unsigned)pb; utab[i * 8 + 3] = (int)(unsigned)(pb >> 32); utab[i * 8 + 4] = u.pm; utab[i * 8 + 5] = u.pn; utab[i * 8 + 6] = u.grp; }
    __syncthreads();
    if (nun == 0) return;
#define UT(i, k) __builtin_amdgcn_readfirstlane(utab[(i) * 8 + (k)])
#define UPTR(i, k) ((const char*)(((unsigned long long)(unsigned)UT(i, k)) | ((unsigned long long)(unsigned)UT(i, (k) + 1) << 32)))
    Unit cur; int ui = 0;
    cur.pm = UT(0, 4); cur.pn = UT(0, 5); cur.grp = UT(0, 6);
    f32x4 acc[2][2][4][2];
#pragma unroll
    for (int a = 0; a < 2; ++a)
#pragma unroll
        for (int b = 0; b < 2; ++b)
#pragma unroll
            for (int m = 0; m < 4; ++m)
#pragma unroll
                for (int n = 0; n < 2; ++n) acc[a][b][m][n] = (f32x4){0.f, 0.f, 0.f, 0.f};
    bf16x8 At[4][2], B0[2][2], B1[2][2];
    const char* cA = UPTR(0, 0); const char* cB = UPTR(0, 2);
    PG8_STAGE(PG8_SB(0, 0), cB, B); PG8_STAGE(PG8_SB(0, 1), cB + hstepB, B); PG8_STAGE(PG8_SA(0, 0), cA, A); PG8_STAGE(PG8_SA(0, 1), cA + hstepA, A);
    if (wr == 1) PG8_BAR;
    PG8_WAIT_V(2); PG8_BAR;
    PG8_STAGE(PG8_SB(1, 0), cB + kstep, B); PG8_STAGE(PG8_SA(1, 0), cA + kstep, A); PG8_STAGE(PG8_SB(1, 1), cB + hstepB + kstep, B);
    PG8_WAIT_V(6); PG8_BAR;
    for (;;) {
        const bool has_next = (ui + 1 < nun);
        const char* nA = has_next ? UPTR(ui + 1, 0) : cA; const char* nB = has_next ? UPTR(ui + 1, 2) : cB;
        for (int t = 0; t < nt; t += 2) {
            const bool last = (t == nt - 2);
            const char* a1 = cA + (size_t)(t + 1) * kstep;
            const char* a2 = last ? nA : cA + (size_t)(t + 2) * kstep; const char* b2 = last ? nB : cB + (size_t)(t + 2) * kstep;
            const char* a3 = a2 + kstep; const char* b3 = b2 + kstep;
            PG8_LDB(B0, 0, 0); PG8_LDB(B1, 0, 1); PG8_SCHED; PG8_LDA(At, 0, 0); PG8_STAGE(PG8_SA(1, 1), a1 + hstepA, A);
            PG8_WAIT_V(8); PG8_WAIT_L(0); PG8_BAR; PG8_MMA(0, 0, At, B0); PG8_MMA(0, 1, At, B1); PG8_BAR; PG8_SCHED;
            PG8_LDA(At, 0, 1); PG8_STAGE(PG8_SB(0, 0), b2, B); PG8_STAGE(PG8_SB(0, 1), b2 + hstepB, B); PG8_STAGE(PG8_SA(0, 0), a2, A);
            PG8_WAIT_V(8); PG8_WAIT_L(0); PG8_BAR; PG8_MMA(1, 0, At, B0); PG8_MMA(1, 1, At, B1); PG8_BAR; PG8_SCHED;
            PG8_LDB(B0, 1, 0); PG8_LDB(B1, 1, 1); PG8_SCHED; PG8_LDA(At, 1, 0); PG8_STAGE(PG8_SA(0, 1), a2 + hstepA, A);
            PG8_WAIT_V(8); PG8_WAIT_L(0); PG8_BAR; PG8_MMA(0, 0, At, B0); PG8_MMA(0, 1, At, B1); PG8_BAR; PG8_SCHED;
            PG8_LDA(At, 1, 1); PG8_STAGE(PG8_SB(1, 0), b3, B); PG8_STAGE(PG8_SB(1, 1), b3 + hstepB, B); PG8_STAGE(PG8_SA(1, 0), a3, A);
            PG8_WAIT_V(8); PG8_WAIT_L(0); PG8_BAR; PG8_MMA(1, 0, At, B0); PG8_MMA(1, 1, At, B1); PG8_BAR; PG8_SCHED;
        }
        if (wr == 0) PG8_BAR;
        { const Params* Pk = (const Params*)__builtin_amdgcn_kernarg_segment_ptr(); asm volatile("" : "+s"(Pk));
          gemm_epilogue(g, Pk, acc, cur, wr, wc, fr, fq, lds + STAGE_BYTES); }
        if (!has_next) break;
#pragma unroll
        for (int a = 0; a < 2; ++a)
#pragma unroll
            for (int b = 0; b < 2; ++b)
#pragma unroll
                for (int m = 0; m < 4; ++m)
#pragma unroll
                    for (int n = 0; n < 2; ++n) acc[a][b][m][n] = (f32x4){0.f, 0.f, 0.f, 0.f};
        ++ui; cur.pm = UT(ui, 4); cur.pn = UT(ui, 5); cur.grp = UT(ui, 6); cA = nA; cB = nB;
        if (wr == 1) PG8_BAR;
    }
    PG8_WAIT_V(0);
    PG8_BAR;
#undef PG8_SA
#undef PG8_SB
#undef PG8_STAGE
#undef PG8_LDA
#undef PG8_LDB
#undef PG8_MMA
#undef PG8_WAIT_V
#undef PG8_WAIT_L
#undef PG8_BAR
#undef PG8_SCHED
#undef UT
#undef UPTR
}

__device__ __forceinline__ double reduce_2pi(double a) { return a - 6.283185307179586 * __builtin_rint(a * 0.15915494309189535); }
__device__ __forceinline__ f32x2 cpow_f(double lr, double li, int n) {
    const float mag = expf((float)((double)n * lr));
    const float ar = (float)reduce_2pi((double)n * li);
    return (f32x2){mag * cosf(ar), mag * sinf(ar)};
}
struct SsmC { double lr, li; float cre, cim; };
__device__ __forceinline__ SsmC ssm_consts(const Params& P, int dir, int g, int p) {
    const int idx = (dir * 32 + g) * 64 + p;
    const float lre = P.in[I_LRE][idx], lim = P.in[I_LIM][idx];
    const float step = expf(P.in[I_LSTEP][dir * 32 + g]);
    SsmC r; r.lr = (double)lre * (double)step; r.li = (double)lim * (double)step;
    const float yr = (float)reduce_2pi(r.li); const float s = sinf(yr), c = cosf(yr), s2 = sinf(0.5f * yr);
    const float em1 = expm1f((float)r.lr);
    const float are = em1 * c - 2.f * s2 * s2, aim = (em1 + 1.f) * s;
    const float den = 1.f / (lre * lre + lim * lim);
    r.cre = (are * lre + aim * lim) * den; r.cim = (aim * lre - are * lim) * den;
    return r;
}
__device__ __forceinline__ f32x2 cmul(f32x2 a, f32x2 b) { return (f32x2){a.x * b.x - a.y * b.y, a.x * b.y + a.y * b.x}; }

__device__ __forceinline__ int rel_bucket(int rel) {
    const int n = rel < 0 ? -rel : rel; int b;
    if (n < 8) b = n; else if (n < 12) b = 8; else if (n < 16) b = 9; else if (n < 23) b = 10; else if (n < 32) b = 11; else if (n < 46) b = 12; else if (n < 64) b = 13; else if (n < 91) b = 14; else b = 15;
    return b + (rel > 0 ? 16 : 0);
}

__device__ __forceinline__ void tr_item(const float* W, int K, int N, bf16_t* WT, int maptype, const float* gain, LAS float* scr, int item, int lane) {
    const int nblk = N / 32, kb = item / nblk, nb = item % nblk, k0 = 64 * kb, n0 = 32 * nb;
#pragma unroll 8
    for (int i = 0; i < 32; ++i) { const int kk = 2 * i + (lane >> 5); float v = W[(size_t)(k0 + kk) * N + n0 + (lane & 31)]; if (gain) v *= gain[k0 + kk]; scr[kk * 33 + (lane & 31)] = v; }
    LDS_WAIT();
    int o0 = n0;
    if (maptype == 1) o0 = (n0 < 2816) ? ((n0 / 128) * 256 + (n0 % 128)) : (((n0 - 2816) / 128) * 256 + 128 + ((n0 - 2816) % 128));
    else if (maptype == 2) o0 = (n0 < 1024) ? n0 : (n0 < 1536 ? 1536 + (n0 - 1024) : 1024 + (n0 - 1536));
    const int c = lane & 7;
#pragma unroll
    for (int j = 0; j < 4; ++j) { const int n = (lane >> 3) + 8 * j; const LAS float* s = scr + (8 * c) * 33 + n;
        u32x4 o; o.x = pk2(s[0 * 33], s[1 * 33]); o.y = pk2(s[2 * 33], s[3 * 33]); o.z = pk2(s[4 * 33], s[5 * 33]); o.w = pk2(s[6 * 33], s[7 * 33]);
        *(u32x4*)(WT + (size_t)(o0 + n) * K + k0 + 8 * c) = o; }
    LDS_WAIT();
}
__device__ __forceinline__ void cvt_range(const float* src, bf16_t* dst, size_t n4, size_t gt, size_t ngt) {
    for (size_t i = gt; i < n4; i += ngt) { const f32x4 v = *(const f32x4*)(src + 4 * i); u32x2 w; w.x = pk2(v[0], v[1]); w.y = pk2(v[2], v[3]); *(u32x2*)(dst + 4 * i) = w; }
}
__device__ __forceinline__ void prep_a(const Params& P, LAS unsigned char* lds, int vcu, int G, int tid) {
    const int lane = tid & 63, wave = tid >> 6;
    const int gw = vcu * 8 + wave, NGW = G * 8; const size_t gt = (size_t)vcu * NTHREADS + tid, ngt = (size_t)G * NTHREADS;
    LAS float* scr = (LAS float*)(lds + wave * 16384);
#pragma unroll 1
    for (int mi = 0; mi < 9; ++mi) {
        const Params* Pm = (const Params*)__builtin_amdgcn_kernarg_segment_ptr(); asm volatile("" : "+s"(Pm));
        const float* W; bf16_t* WT; int K = 1024, N = 1024, mt = 0; const float* gain = nullptr;
        switch (mi) {
        case 0: W = Pm->in[I_F1W13]; WT = Pm->W13T; N = 5632; mt = 1; break;
        case 1: W = Pm->in[I_F1W2]; WT = Pm->W2T; K = 2816; break;
        case 2: W = Pm->in[I_WIN]; WT = Pm->WinT; N = 2048; mt = 2; gain = Pm->in[I_G1]; break;
        case 3: W = Pm->in[I_GLUW]; WT = Pm->GluT; K = 512; N = 512; break;
        case 4: W = Pm->in[I_WOUT]; WT = Pm->WoutT; break;
        case 5: W = Pm->in[I_WKV]; WT = Pm->WkvT; N = 2048; break;
        case 6: W = Pm->in[I_WO]; WT = Pm->WoT; break;
        case 7: W = Pm->in[I_F2W13]; WT = Pm->W13bT; N = 5632; mt = 1; gain = Pm->in[I_G3]; break;
        default: W = Pm->in[I_F2W2]; WT = Pm->W2bT; K = 2816; break;
        }
        const int tot = (K / 64) * (N / 32);
        for (int it = gw; it < tot; it += NGW) tr_item(W, K, N, WT, mt, gain, scr, it, lane);
    }
    { const Params* Pm = (const Params*)__builtin_amdgcn_kernarg_segment_ptr(); asm volatile("" : "+s"(Pm)); }
    asm volatile("" ::: "memory");
    cvt_range(P.in[I_XP], BUF_XB(P), (size_t)NPROMPT * 256, gt, ngt);
    cvt_range(P.in[I_XS], BUF_XB(P) + (size_t)NPROMPT * 1024, (size_t)(NTOK - NPROMPT) * 256, gt, ngt);
    cvt_range(P.in[I_MP], P.memb, (size_t)4 * 256 * 256, gt, ngt);
    cvt_range(P.in[I_MS], P.memb + (size_t)4 * 256 * 1024, (size_t)16 * 256 * 256, gt, ngt);
    cvt_range(P.in[I_WQ], P.WqN, (size_t)1024 * 256, gt, ngt);
    for (size_t i = gt; i < (size_t)4 * NTOK * 2 / 4; i += ngt) *(f32x4*)(P.stats + 4 * i) = (f32x4){0.f, 0.f, 0.f, 0.f};
    for (size_t i = gt; i < 4 * 257; i += ngt) { const int h = (int)i / 257, idx = (int)i % 257; P.btab[h * 260 + idx] = P.in[I_RELB][rel_bucket(idx - 128) * 4 + h] * LOG2E; }
    for (size_t e = gt; e < (size_t)64 * 33 * 64; e += ngt) {
        const int p = (int)e & 63, n = (int)(e >> 6) % 33, dg = (int)(e >> 6) / 33;
        const SsmC sc = ssm_consts(P, dg >> 5, dg & 31, p);
        *(f32x2*)(P.TA + 2 * e) = cpow_f(sc.lr, sc.li, n);
        if (n == 0) *(f32x2*)(P.TC + 2 * (size_t)(dg * 64 + p)) = (f32x2){sc.cre, sc.cim};
    }
}
__device__ __forceinline__ void colsum_rows(const bf16_t* Wt, int nrows, const float* gam, const float* bet, float* cs1, float* cs2, int gw, int NGW, int lane) {
    float r[16];
#pragma unroll
    for (int e = 0; e < 16; ++e) r[e] = bet[lane * 16 + e] / gam[lane * 16 + e];
    for (int n = gw; n < nrows; n += NGW) {
        const u32x4 a = *(const u32x4*)(Wt + (size_t)n * 1024 + lane * 16), b = *(const u32x4*)(Wt + (size_t)n * 1024 + lane * 16 + 8);
        const float v[16] = {bflo(a.x), bfhi(a.x), bflo(a.y), bfhi(a.y), bflo(a.z), bfhi(a.z), bflo(a.w), bfhi(a.w), bflo(b.x), bfhi(b.x), bflo(b.y), bfhi(b.y), bflo(b.z), bfhi(b.z), bflo(b.w), bfhi(b.w)};
        float s1 = 0.f, s2 = 0.f;
#pragma unroll
        for (int e = 0; e < 16; ++e) { s1 += v[e]; s2 += v[e] * r[e]; }
#pragma unroll
        for (int o = 1; o < 64; o <<= 1) { s1 += __shfl_xor(s1, o); s2 += __shfl_xor(s2, o); }
        if (lane == 0) { cs1[n] = s1; cs2[n] = s2; }
    }
}
__device__ __forceinline__ void prep_b(const Params& P, int vcu, int G, int tid) {
    const int lane = tid & 63, wave = tid >> 6;
    const int gw = vcu * 8 + wave, NGW = G * 8; const size_t gt = (size_t)vcu * NTHREADS + tid, ngt = (size_t)G * NTHREADS;
    colsum_rows(P.WinT, 2048, P.in[I_G1], P.in[I_B1], P.cs_in, P.cs_in + 2048, gw, NGW, lane);
    colsum_rows(P.W13bT, 5632, P.in[I_G3], P.in[I_B3], P.cs_f2, P.cs_f2 + 5632, gw, NGW, lane);
    for (size_t e = gt; e < (size_t)32 * 2 * 32 * 256; e += ngt) {
        const int g = (int)(e >> 14), dir = (int)(e >> 13) & 1, tau = (int)(e >> 8) & 31, i = (int)(e >> 4) & 15, j = (int)e & 15;
        const int dg = dir * 32 + g; const f32x2* ta = (const f32x2*)P.TA + (size_t)(dg * 33 + tau) * 64; const f32x2* tc = (const f32x2*)P.TC + dg * 64;
        float sum = 0.f;
        for (int p = 0; p < 64; ++p) {
            const int idx = dg * 64 + p; const f32x2 B = {P.in[I_BRE][idx * 16 + j], P.in[I_BIM][idx * 16 + j]};
            const int ci = (dg * 16 + i) * 64 + p; const f32x2 C = {P.in[I_CRE][ci], P.in[I_CIM][ci]};
            sum += cmul(cmul(C, tc[p]), cmul(B, ta[p])).x;
        }
        P.KT[e] = sum;
    }
    for (size_t e = gt; e < (size_t)32 * 256 * 512; e += ngt) {
        const int g = (int)(e / (256 * 512)), row = (int)((e / 512) % 256), k = (int)(e % 512), s = k >> 4, j = k & 15, which = row >> 6, p = row & 63, dir = which >> 1;
        const int n = dir == 0 ? 31 - s : s; const int dg = dir * 32 + g;
        const f32x2 ap = ((const f32x2*)P.TA)[(size_t)(dg * 33 + n) * 64 + p], co = ((const f32x2*)P.TC)[dg * 64 + p];
        const int idx = dg * 64 + p; const f32x2 B = {P.in[I_BRE][idx * 16 + j], P.in[I_BIM][idx * 16 + j]};
        const f32x2 z = cmul(ap, cmul(co, B));
        P.Pcat[e] = (bf16_t)f2bf((which & 1) ? z.y : z.x);
    }
}
__device__ __forceinline__ void mcat_fill(const Params& P, int vcu, int G, int tid) {
    const size_t gt = (size_t)vcu * NTHREADS + tid, ngt = (size_t)G * NTHREADS;
    for (size_t e = gt; e < (size_t)32 * 512 * 768; e += ngt) {
        const int g = (int)(e / (512 * 768)), r = (int)((e / 768) % 512), col = (int)(e % 768), t = r >> 4, i = r & 15;
        float val;
        if (col < 512) { const int s = col >> 4, j = col & 15; val = 0.f;
            if (s <= t) val += P.KT[((size_t)(g * 2 + 0) * 32 + (t - s)) * 256 + i * 16 + j];
            if (s >= t) val += P.KT[((size_t)(g * 2 + 1) * 32 + (s - t)) * 256 + i * 16 + j];
            if (s == t && i == j) val += P.in[I_SSMD][g * 16 + i];
        } else { const int pp = col - 512, which = pp >> 6, p = pp & 63, dir = which >> 1; const int n = dir == 0 ? t + 1 : 32 - t; const int dg = dir * 32 + g;
            const f32x2 ap = ((const f32x2*)P.TA)[(size_t)(dg * 33 + n) * 64 + p];
            const int ci = (dg * 16 + i) * 64 + p; const f32x2 z = cmul((f32x2){P.in[I_CRE][ci], P.in[I_CIM][ci]}, ap);
            val = (which & 1) ? -z.y : z.x; }
        P.Mcat[e] = (bf16_t)f2bf(val);
    }
}

__device__ __forceinline__ void scan_phase(const Params& P, int vcu, int G, int tid) {
    const int lane = tid & 63, wave = tid >> 6; const int gw = vcu * 8 + wave, NGW = G * 8;
    for (int item = gw; item < 20 * 64; item += NGW) {
        const int seq = item >> 6, g = (item >> 1) & 31, dir = item & 1, p = lane;
        const int L = seq < 4 ? 8192 : 4096, tok0 = seq < 4 ? seq * 8192 : NPROMPT + (seq - 4) * 4096, nch = L / 32, cb = tok0 / 32;
        const f32x2 aT = ((const f32x2*)P.TA)[(size_t)((dir * 32 + g) * 33 + 32) * 64 + p];
        const float* X = BUF_X(P) + (size_t)g * 3072 * 256 + dir * 128 + p; bf16_t* Ac = BUF_ACAT(P) + (size_t)g * 3072 * 768 + 512 + dir * 128 + p;
        float sr = 0.f, si = 0.f;
        for (int c0 = 0; c0 < nch; c0 += 8) {
            float xr[8], xi[8];
#pragma unroll
            for (int k = 0; k < 8; ++k) { const int row = cb + (dir ? nch - 1 - (c0 + k) : c0 + k); xr[k] = X[(size_t)row * 256]; xi[k] = X[(size_t)row * 256 + 64]; }
#pragma unroll
            for (int k = 0; k < 8; ++k) { const int row = cb + (dir ? nch - 1 - (c0 + k) : c0 + k);
                Ac[(size_t)row * 768] = (bf16_t)f2bf(sr); Ac[(size_t)row * 768 + 64] = (bf16_t)f2bf(si);
                const float nr = aT.x * sr - aT.y * si + xr[k], ni = aT.x * si + aT.y * sr + xi[k]; sr = nr; si = ni; }
        }
    }
}

__device__ __forceinline__ int crow(int r, int hi) { return (r & 3) + 8 * (r >> 2) + 4 * hi; }
#define KSWZ(row, colB) ((row) * 256 + ((colB) ^ (((row) & 7) << 4)))
constexpr int AT_K = 0, AT_V = 49152, AT_VSZ = 16384, AT_WS = AT_V + 4 * AT_VSZ, AT_Q = AT_WS + 8 * 512, AT_BT = AT_Q + 32768;
static_assert(AT_BT + 260 * 4 <= LDS_BYTES, "attention LDS map");
#define MFMA32(a, b, c) __builtin_amdgcn_mfma_f32_32x32x16_bf16((a), (b), (c), 0, 0, 0)
#define GLDS16(gptr, ldsptr) __builtin_amdgcn_global_load_lds((const unsigned*)(gptr), (LAS unsigned*)(ldsptr), 16, 0, 0)
__device__ __forceinline__ bf16x8 pack8(const f32x16& p, int s) {
    u32x4 w; w.x = pk2(p[8 * s + 0], p[8 * s + 1]); w.y = pk2(p[8 * s + 2], p[8 * s + 3]); w.z = pk2(p[8 * s + 4], p[8 * s + 5]); w.w = pk2(p[8 * s + 6], p[8 * s + 7]);
    return __builtin_bit_cast(bf16x8, w);
}
__device__ __forceinline__ void tile_bias(int t, int qw, float btL, float btR, bool& nearb, float& cb) { const int kmin = t * 64; const bool fl = (kmin + 63 - qw <= -128), fr = (kmin - (qw + 31) >= 128); nearb = !(fl || fr); cb = fl ? btL : btR; }
__device__ __forceinline__ void attn_unit(const Params& P, LAS unsigned char* lds, int seq, int h, int qb, float lam, int tid_in) {
    int tid = tid_in; asm volatile("" : "+v"(tid));
    const int lane = tid & 63, r32 = lane & 31, hi = lane >> 5; const int wid = __builtin_amdgcn_readfirstlane(tid >> 6);
    const int qg = wid >> 1, m = wid & 1;
    const int L = seq < 4 ? 8192 : 4096, tok0 = seq < 4 ? seq * 8192 : NPROMPT + (seq - 4) * 4096, NT = L / 64;
    const int q0 = qb * 128, qw = q0 + qg * 32;
    LAS unsigned char* Ks = lds + AT_K; LAS unsigned char* Vs = lds + AT_V; LAS float* wsf = (LAS float*)(lds + AT_WS + wid * 512);
    LAS unsigned char* Qs = lds + AT_Q; LAS float* bt = (LAS float*)(lds + AT_BT);
    for (int i = tid; i < 257; i += NTHREADS) bt[i] = P.btab[h * 260 + i];
#pragma unroll
    for (int i = 0; i < 4; ++i) { const int idx = tid + NTHREADS * i, row = idx >> 4, ch = idx & 15;
        const u32x4 v = *(const u32x4*)(BUF_Q(P) + (size_t)(tok0 + q0 + row) * 512 + h * 128 + ch * 8); *(LAS u32x4*)(Qs + KSWZ(row, ch * 16)) = v; }
    unsigned ko0, ko1, vo0, vo1;
    { int j = 2 * wid, row = 4 * j + (lane >> 4), lc = (lane & 15) ^ (row & 7); ko0 = (unsigned)(row * 512 + lc * 8) * 2u;
      j = 2 * wid + 1; row = 4 * j + (lane >> 4); lc = (lane & 15) ^ (row & 7); ko1 = (unsigned)(row * 512 + lc * 8) * 2u;
      j = 2 * wid; row = 8 * j + (lane >> 3); lc = (lane & 7) ^ ((row >> 1) & 7); vo0 = (unsigned)(row * NTOK + lc * 8) * 2u;
      j = 2 * wid + 1; row = 8 * j + (lane >> 3); lc = (lane & 7) ^ ((row >> 1) & 7); vo1 = (unsigned)(row * NTOK + lc * 8) * 2u; }
    const char* kbase = (const char*)(BUF_K(P) + (size_t)tok0 * 512 + h * 128);
    const char* vbase = (const char*)(BUF_VT(P) + (size_t)(h * 128) * NTOK + tok0);
    const int pdst = wid * 2048;
#define ATT_DMA(t, koff_, voff_) do { const char* kb_ = kbase + (size_t)(t) * (64 * 512 * 2); const char* vb_ = vbase + (size_t)(t) * 128; \
                             GLDS16(kb_ + ko0, Ks + (koff_) + pdst); GLDS16(kb_ + ko1, Ks + (koff_) + pdst + 1024); \
                             GLDS16(vb_ + vo0, Vs + (voff_) + pdst); GLDS16(vb_ + vo1, Vs + (voff_) + pdst + 1024); } while (0)
    asm volatile("s_waitcnt vmcnt(0) lgkmcnt(0)" ::: "memory");
    ATT_DMA(0, 0, 0); ATT_DMA(1, 16384, AT_VSZ); ATT_DMA(2, 32768, 2 * AT_VSZ);
    asm volatile("s_waitcnt vmcnt(4) lgkmcnt(0)" ::: "memory");
    __builtin_amdgcn_s_barrier(); asm volatile("" ::: "memory");
    f32x16 O[4];
#pragma unroll
    for (int d = 0; d < 4; ++d)
#pragma unroll
        for (int i = 0; i < 16; ++i) O[d][i] = 0.f;
    float mrun = 0.f, lsum = 0.f;
    const int qpos = qw + r32;
    const int vsw = (r32 >> 1) & 7;
    int vcur = 0, v1 = AT_VSZ, v2 = 2 * AT_VSZ, v3 = 3 * AT_VSZ; int k1 = 16384, k2 = 32768, k3 = 0;
    bf16x8 pa[4];
#define ATT_S(P0, P1, koff_, cinit_) do { _Pragma("unroll") for (int i = 0; i < 16; ++i) { P0[i] = (cinit_); P1[i] = (cinit_); } \
        _Pragma("unroll") for (int d0 = 0; d0 < 4; ++d0) { const int colB = (m * 64 + d0 * 16 + hi * 8) * 2; \
            const bf16x8 k0 = *(const LAS bf16x8*)(Ks + (koff_) + KSWZ(r32, colB)); const bf16x8 k1_ = *(const LAS bf16x8*)(Ks + (koff_) + KSWZ(32 + r32, colB)); \
            const bf16x8 qf = *(const LAS bf16x8*)(Qs + KSWZ(qg * 32 + r32, colB)); \
            P0 = MFMA32(k0, qf, P0); P1 = MFMA32(k1_, qf, P1); asm volatile("" ::: "memory"); } } while (0)
#define ATT_PV(voff_) do { _Pragma("unroll") for (int d0 = 0; d0 < 4; ++d0) _Pragma("unroll") for (int s = 0; s < 4; ++s) { const LAS unsigned char* vr = Vs + (voff_) + (32 * d0 + r32) * 128; \
        const bf16x8 vf = *(const LAS bf16x8*)(vr + (((2 * s + hi) ^ vsw) << 4));     \
        O[d0] = MFMA32(pa[s], vf, O[d0]); if (s == 3) asm volatile("" ::: "memory"); } } while (0)
#define ATT_STEP(t, PC0, PC1, PN0, PN1, DOMAX) do { \
        if ((t) + 3 < NT) ATT_DMA((t) + 3, k3, v3); \
        bool near_c; float cb_c; tile_bias((t), qw, btL, btR, near_c, cb_c); (void)cb_c; \
        if ((t) + 1 < NT) { const int t1_ = (t) + 1; const int kmin_n = t1_ * 64; const bool fl_n = (kmin_n + 63 - qw <= -128), fr_n = (kmin_n - (qw + 31) >= 128); \
            const float cin = ((fl_n || fr_n) ? (fl_n ? btL : btR) : 0.f) - mrun; ATT_S(PN0, PN1, k1, cin); } \
        if (near_c) { int qp_ = qpos, hn_ = hi; asm volatile("" : "+v"(qp_), "+v"(hn_)); const int kmin = (t) * 64; \
            _Pragma("unroll") for (int i = 0; i < 16; ++i) { const int rel = kmin + crow(i, hn_) - qp_; const int i0 = min(max(rel, -128), 128) + 128, i1 = min(max(rel + 32, -128), 128) + 128; PC0[i] += bt[i0]; PC1[i] += bt[i1]; if ((i & 3) == 3) asm volatile("" ::: "memory"); } } \
        float mx = 0.f;     \
        if (DOMAX) { mx = fmaxf(fmaxf(PC0[0], PC1[0]), PC0[1]); \
        _Pragma("unroll") for (int i = 1; i < 15; i += 2) { mx = fmaxf(fmaxf(mx, PC1[i]), PC0[i + 1]); mx = fmaxf(fmaxf(mx, PC1[i + 1]), PC0[i + 2 < 16 ? i + 2 : 15]); } \
        mx = fmaxf(mx, PC1[15]); \
        { auto rr_ = __builtin_amdgcn_permlane32_swap(__float_as_uint(mx), __float_as_uint(mx), false, false); mx = fmaxf(__uint_as_float(rr_[0]), __uint_as_float(rr_[1])); } }     \
        if ((DOMAX) && ((t) == 0 || __any(mx > 4.f))) { \
            const float dl = ((t) == 0) ? mx : fmaxf(mx, 0.f); const float al = __builtin_amdgcn_exp2f(-dl); mrun += dl; \
            _Pragma("unroll") for (int i = 0; i < 16; ++i) { PC0[i] -= dl; PC1[i] -= dl; } \
            if ((t) + 1 < NT) { _Pragma("unroll") for (int i = 0; i < 16; ++i) { PN0[i] -= dl; PN1[i] -= dl; } } \
            if ((t) != 0) { lsum *= al; if (hi == 0) wsf[r32] = al; LDS_WAIT(); \
                _Pragma("unroll") for (int i = 0; i < 16; ++i) { const float a = wsf[crow(i, hi)]; _Pragma("unroll") for (int d = 0; d < 4; ++d) O[d][i] *= a; } } \
        } \
        float ps = 0.f; \
        _Pragma("unroll") for (int i = 0; i < 16; ++i) { PC0[i] = __builtin_amdgcn_exp2f(PC0[i]); PC1[i] = __builtin_amdgcn_exp2f(PC1[i]); ps += PC0[i] + PC1[i]; } \
        lsum += ps; \
        pa[0] = pack8(PC0, 0); pa[1] = pack8(PC0, 1); pa[2] = pack8(PC1, 0); pa[3] = pack8(PC1, 1); \
        ATT_PV(vcur); \
        if ((t) + 3 < NT) asm volatile("s_waitcnt vmcnt(4) lgkmcnt(0)" ::: "memory"); else asm volatile("s_waitcnt vmcnt(0) lgkmcnt(0)" ::: "memory"); \
        __builtin_amdgcn_s_barrier(); asm volatile("" ::: "memory"); \
        { const int tv = vcur; vcur = v1; v1 = v2; v2 = v3; v3 = tv; const int tk = k1; k1 = k2; k2 = k3; k3 = tk; } \
    } while (0)
    f32x16 pA0, pA1, pB0, pB1;
    const float btL = bt[0], btR = bt[256];
    { bool near0; float cb0; tile_bias(0, qw, btL, btR, near0, cb0); const float cin0 = near0 ? 0.f : cb0; ATT_S(pA0, pA1, 0, cin0); }
    asm volatile("s_waitcnt lgkmcnt(0)" ::: "memory"); __builtin_amdgcn_s_barrier(); asm volatile("" ::: "memory");
    for (int t = 0; t < NT; t += 2) {
        ATT_STEP(t, pA0, pA1, pB0, pB1, 1);
        ATT_STEP(t + 1, pB0, pB1, pA0, pA1, 0);
    }
    asm volatile("s_waitcnt lgkmcnt(0)" ::: "memory");
    __syncthreads();
#undef ATT_S
#undef ATT_STEP
#undef ATT_DMA
#undef ATT_PV
    int r32e = r32, hie = hi, lanee = lane; asm volatile("" : "+v"(r32e), "+v"(hie), "+v"(lanee));
    lsum += __shfl_xor(lsum, 32); if (hie == 0) wsf[r32e] = 1.f / lsum;
    LDS_WAIT();
    LAS float* xb = (LAS float*)(lds + AT_K) + qg * 4096 + lanee;
#pragma unroll
    for (int i = 0; i < 16; ++i) { const float il = wsf[crow(i, hie)];
#pragma unroll
        for (int d = 0; d < 4; ++d) O[d][i] *= il; }
    if (m == 1) {
#pragma unroll
        for (int d = 0; d < 4; ++d)
#pragma unroll
            for (int i = 0; i < 16; ++i) xb[(d * 16 + i) * 64] = O[d][i];
    }
    LDS_WAIT();
    __syncthreads();
    if (m == 0) {
        float ssq[16];
#pragma unroll
        for (int i = 0; i < 16; ++i) { float a = 0.f;
#pragma unroll
            for (int d = 0; d < 4; ++d) { const float v = O[d][i] - lam * xb[(d * 16 + i) * 64]; O[d][i] = v; a += v * v; }
            ssq[i] = a; }
#pragma unroll
        for (int i = 0; i < 16; ++i) {
#pragma unroll
            for (int o = 1; o < 32; o <<= 1) ssq[i] += __shfl_xor(ssq[i], o);
            ssq[i] = rsqrtf(ssq[i] * (1.f / 128.f) + 1e-5f); }
        bf16_t* outp = BUF_CAT(P) + (size_t)(tok0 + qw) * 1024 + h * 128 + r32e;
#pragma unroll
        for (int d = 0; d < 4; ++d) { const float gs = P.in[I_SUBG][32 * d + r32e] * 0.8f;
#pragma unroll
            for (int i = 0; i < 16; ++i) outp[(size_t)crow(i, hie) * 1024 + 32 * d] = (bf16_t)f2bf(O[d][i] * ssq[i] * gs); }
    }
    LDS_WAIT();
    __syncthreads();
}
__device__ __forceinline__ void attn_phase(const Params& P, LAS unsigned char* lds, int vcu, int G, int tid) {
    const int lane = tid & 63;
    float a = P.in[I_DLAM][lane] * P.in[I_DLAM][64 + lane], b = P.in[I_DLAM][128 + lane] * P.in[I_DLAM][192 + lane];
#pragma unroll
    for (int o = 1; o < 64; o <<= 1) { a += __shfl_xor(a, o); b += __shfl_xor(b, o); }
    const float lam = expf(a) - expf(b) + 0.2f;
    for (int u = vcu; u < 1024; u += G) attn_unit(P, lds, u >> 8, (u >> 6) & 3, u & 63, lam, tid);
    for (int u = vcu; u < 2048; u += G) attn_unit(P, lds, 4 + (u >> 7), (u >> 5) & 3, u & 31, lam, tid);
}

__device__ __forceinline__ void softmax_pass(const Params& P, int vcu, int G, int tid) {
    const int lane = tid & 63, wave = tid >> 6; const int gw = vcu * 8 + wave, NGW = G * 8;
    for (int row = gw; row < NTOK; row += NGW) {
        bf16_t* p = BUF_PM(P) + (size_t)row * 1024 + lane * 16;
        const u32x4 a = *(const u32x4*)p, b = *(const u32x4*)(p + 8);
        float v[16] = {bflo(a.x), bfhi(a.x), bflo(a.y), bfhi(a.y), bflo(a.z), bfhi(a.z), bflo(a.w), bfhi(a.w), bflo(b.x), bfhi(b.x), bflo(b.y), bfhi(b.y), bflo(b.z), bfhi(b.z), bflo(b.w), bfhi(b.w)};
        float mx = v[0];
#pragma unroll
        for (int e = 1; e < 16; ++e) mx = fmaxf(mx, v[e]);
#pragma unroll
        for (int o = 1; o < 16; o <<= 1) mx = fmaxf(mx, __shfl_xor(mx, o));
        float l = 0.f;
#pragma unroll
        for (int e = 0; e < 16; ++e) { v[e] = __builtin_amdgcn_exp2f(v[e] - mx); l += v[e]; }
#pragma unroll
        for (int o = 1; o < 16; o <<= 1) l += __shfl_xor(l, o);
        const float il = 1.f / l;
        u32x4 w0, w1; w0.x = pk2(v[0] * il, v[1] * il); w0.y = pk2(v[2] * il, v[3] * il); w0.z = pk2(v[4] * il, v[5] * il); w0.w = pk2(v[6] * il, v[7] * il);
        w1.x = pk2(v[8] * il, v[9] * il); w1.y = pk2(v[10] * il, v[11] * il); w1.z = pk2(v[12] * il, v[13] * il); w1.w = pk2(v[14] * il, v[15] * il);
        *(u32x4*)p = w0; *(u32x4*)(p + 8) = w1;
    }
}

__device__ __forceinline__ void final_ln(const Params& P, int vcu, int G, int tid) {
    const int lane = tid & 63, wave = tid >> 6; const int gw = vcu * 8 + wave, NGW = G * 8;
    f32x4 gv[4], bv[4];
#pragma unroll
    for (int j = 0; j < 4; ++j) { gv[j] = *(const f32x4*)(P.in[I_G4] + lane * 4 + 256 * j); bv[j] = *(const f32x4*)(P.in[I_B4] + lane * 4 + 256 * j); }
    for (int row = gw; row < NTOK; row += NGW) {
        float* xr = P.out + (size_t)row * 1024 + lane * 4; f32x4 v[4]; float s = 0.f;
#pragma unroll
        for (int j = 0; j < 4; ++j) { v[j] = *(const f32x4*)(xr + 256 * j); s += (v[j][0] + v[j][1]) + (v[j][2] + v[j][3]); }
#pragma unroll
        for (int o = 1; o < 64; o <<= 1) s += __shfl_xor(s, o);
        const float mean = s * (1.f / 1024.f); float q = 0.f;
#pragma unroll
        for (int j = 0; j < 4; ++j) { v[j] = v[j] - mean; q += (v[j][0] * v[j][0] + v[j][1] * v[j][1]) + (v[j][2] * v[j][2] + v[j][3] * v[j][3]); }
#pragma unroll
        for (int o = 1; o < 64; o <<= 1) q += __shfl_xor(q, o);
        const float rstd = rsqrtf(q * (1.f / 1024.f) + LN_EPS);
#pragma unroll
        for (int j = 0; j < 4; ++j) *(f32x4*)(xr + 256 * j) = v[j] * rstd * gv[j] + bv[j];
    }
}

__device__ __forceinline__ GD make_gd(const Params& P, int gi) {
    GD g; g.a_s1 = g.a_s2 = g.b_s1 = g.b_s2 = 0; g.gdiv = 1; g.bseq = 0; g.ngrp = 1; g.stage = 0; g.perm = 1; g.K = 1024; g.lda = g.ldb = 2048; g.nM = 384; g.nN = 4; g.mode = M_RESID; g.A = nullptr; g.B = nullptr;
    switch (gi) {
    case 0: g.A = (const char*)P.memb; g.B = (const char*)P.WkvT; g.nM = 20; g.nN = 8; g.mode = M_KVMEM; break;
    case 1: g.A = (const char*)BUF_XB(P); g.B = (const char*)P.W13T; g.nN = 22; g.mode = M_SWIGLU; g.stage = 1; break;
    case 2: g.A = (const char*)P.kvm; g.lda = 4096; g.a_s1 = 256 * 4096; g.a_s2 = 512; g.B = (const char*)P.WqN; g.b_s2 = 512; g.gdiv = 4; g.K = 256; g.nM = 1; g.nN = 4; g.ngrp = 80; g.mode = M_WQK; break;
    case 3: g.A = (const char*)P.WoT; g.a_s2 = 512; g.B = (const char*)P.kvm + 2048; g.ldb = 4096; g.b_s1 = 256 * 4096; g.b_s2 = 512; g.gdiv = 4; g.K = 256; g.nM = 4; g.nN = 1; g.ngrp = 80; g.mode = M_VWO; break;
    case 4: g.A = (const char*)BUF_H1(P); g.B = (const char*)P.W2T; g.lda = g.ldb = 5632; g.K = 2816; g.stage = 1; g.perm = 0; break;
    case 5: g.A = (const char*)BUF_Y1B(P); g.B = (const char*)P.WinT; g.nN = 6; g.mode = M_QKU; break;
    case 6: g.A = (const char*)(P.WinT + 1536 * 1024); g.B = (const char*)BUF_Y1B(P); g.nM = 2; g.nN = 384; g.mode = M_VT; break;
    case 7: g.A = (const char*)BUF_ACAT(P); g.lda = 1536; g.a_s1 = 3072 * 1536; g.B = (const char*)P.Pcat; g.ldb = 1024; g.b_s1 = 256 * 1024; g.K = 512; g.nM = 12; g.nN = 1; g.ngrp = 32; g.mode = M_SSM1; g.perm = 0; break;
    case 8: g.A = (const char*)BUF_ACAT(P); g.lda = 1536; g.a_s1 = 3072 * 1536; g.B = (const char*)P.Mcat; g.ldb = 1536; g.b_s1 = 512 * 1536; g.K = 768; g.nM = 12; g.nN = 2; g.ngrp = 32; g.mode = M_SSM3; break;
    case 9: g.A = (const char*)BUF_Z(P); g.B = (const char*)P.GluT; g.lda = g.ldb = 1024; g.K = 512; g.nN = 2; g.mode = M_GLU; break;
    case 10: g.A = (const char*)BUF_CAT(P); g.B = (const char*)P.WoutT; g.stage = 2; g.perm = 0; break;
    case 11: g.A = (const char*)BUF_Y2B(P); g.B = (const char*)P.Wqk; g.b_s1 = 1024 * 2048; g.bseq = 1; g.mode = M_SCORES; break;
    case 12: g.A = (const char*)BUF_PM(P); g.B = (const char*)P.VWo; g.b_s1 = 1024 * 2048; g.bseq = 1; g.stage = 3; g.perm = 0; break;
    case 13: g.A = (const char*)BUF_Y3B(P); g.B = (const char*)P.W13bT; g.nN = 22; g.mode = M_SWIGLU; g.stage = 4; break;
    default: g.A = (const char*)BUF_H2(P); g.B = (const char*)P.W2bT; g.lda = g.ldb = 5632; g.K = 2816; g.stage = 4; g.perm = 0; break;
    }
    return g;
}

#define XB_TMO      128
#define XB_XCNT(j)  (256  + 64 * (j))
#define XB_XSUB(j)  (1280 + 64 * (j))
#define XB_XGEN(j)  (2304 + 64 * (j))
#define XB_TOP      3328
#define XB_TOPGEN   3392
#define XCD_BAR_WORDS 3456
#define XB_SPIN_CAP (1u << 18)
__device__ __forceinline__ unsigned xb_ld(unsigned* p)              { return __hip_atomic_load(p, __ATOMIC_RELAXED, __HIP_MEMORY_SCOPE_AGENT); }
__device__ __forceinline__ unsigned xb_add(unsigned* p, unsigned v) { return __hip_atomic_fetch_add(p, v, __ATOMIC_RELAXED, __HIP_MEMORY_SCOPE_AGENT); }
__device__ __forceinline__ unsigned xb_xcc_id() { return (unsigned)__builtin_amdgcn_s_getreg((3 << 11) | 20) & 0xFu; }
#define XB_SPIN(cond, bar) do { unsigned _sp = 0; while (cond) { __builtin_amdgcn_s_sleep(1); \
    if ((++_sp & 255u) == 0u) { if (xb_ld(&(bar)[XB_TMO])) break; if (_sp > XB_SPIN_CAP) { atomicAdd(&(bar)[XB_TMO], 1u); break; } } } } while (0)
struct XcdBarrier { unsigned* bar; unsigned x; volatile LAS unsigned* st; };
__device__ __forceinline__ void xcd_barrier_complete(unsigned* bar, unsigned x, unsigned& nloc, unsigned& nx) {
    const unsigned G = gridDim.x * gridDim.y * gridDim.z;
    unsigned sum, cnt, mine, sp = 0u;
    for (;;) {
        sum = 0u; cnt = 0u; mine = 0u;
#pragma unroll
        for (unsigned j = 0; j < 16; ++j) { const unsigned c = xb_ld(&bar[XB_XCNT(j)]); sum += c; cnt += (c > 0u) ? 1u : 0u; mine = (j == x) ? c : mine; }
        if (sum == G) break;
        __builtin_amdgcn_s_sleep(1);
        if ((++sp & 255u) == 0u) { if (xb_ld(&bar[XB_TMO])) break; if (sp > XB_SPIN_CAP) { atomicAdd(&bar[XB_TMO], 1u); break; } }
    }
    nloc = mine > 0u ? mine : 1u; nx = cnt > 0u ? cnt : 1u;
}
__device__ __forceinline__ void xcd_barrier(unsigned* bar, volatile LAS unsigned* st) {
    asm volatile("s_waitcnt vmcnt(0)" ::: "memory");
    __syncthreads();
    if (threadIdx.x == 0) {
        const unsigned x = xb_xcc_id();
        __builtin_amdgcn_s_waitcnt(0);
        unsigned nloc = st[0], nx = st[1];
        if (nloc == 0u) { xcd_barrier_complete(bar, x, nloc, nx); st[0] = nloc; st[1] = nx; }
        const unsigned old = xb_add(&bar[XB_XSUB(x)], 1u);
        const unsigned gen = old / nloc;
        if (old + 1u == (gen + 1u) * nloc) {
            __builtin_amdgcn_fence(__ATOMIC_RELEASE, "agent");
            asm volatile("s_waitcnt vmcnt(0)" ::: "memory");
            const unsigned og = xb_add(&bar[XB_TOP], 1u);
            const unsigned tg = og / nx;
            if (og + 1u == (tg + 1u) * nx) xb_add(&bar[XB_TOPGEN], 1u);
            else XB_SPIN(xb_ld(&bar[XB_TOPGEN]) == tg, bar);
            __builtin_amdgcn_fence(__ATOMIC_ACQUIRE, "agent");
            xb_add(&bar[XB_XGEN(x)], 1u);
            asm volatile("s_waitcnt vmcnt(0)" ::: "memory");
        } else {
            XB_SPIN(xb_ld(&bar[XB_XGEN(x)]) == gen, bar);
            __builtin_amdgcn_fence(__ATOMIC_ACQUIRE, "agent");
            asm volatile("s_waitcnt vmcnt(0)" ::: "memory");
        }
    }
    __syncthreads();
}

template <int PH> __device__ __forceinline__ void run_phase(LAS unsigned char* lds, int vcu, int G, int bx) {
    const Params* Pk = (const Params*)__builtin_amdgcn_kernarg_segment_ptr(); asm volatile("" : "+s"(Pk));
    int tz = 0; asm volatile("" : "+v"(tz)); const int tid = (int)threadIdx.x + tz;
    const Params& Q = *Pk;
    constexpr int gfirst[14] = {0, 0, 2, 5, 7, 8, 8, 9, 10, 11, 12, 13, 14, 15};
    if constexpr (PH == 0) prep_a(Q, lds, vcu, G, tid);
    else if constexpr (PH == 1) prep_b(Q, vcu, G, tid);
    else if constexpr (PH == 2) mcat_fill(Q, vcu, G, tid);
    else if constexpr (PH == 3) colsum_rows(Q.Wqk, 20 * 1024, Q.in[I_G2], Q.in[I_B2], Q.cs_m, Q.cs_m + 20 * 1024, vcu * 8 + (tid >> 6), G * 8, tid & 63);
    else if constexpr (PH == 5) { scan_phase(Q, vcu, G, tid); attn_phase(Q, lds, vcu, G, tid); }
    if constexpr (gfirst[PH + 1] > gfirst[PH]) {
        __syncthreads();
#pragma unroll 1
        for (int gi = gfirst[PH]; gi < gfirst[PH + 1]; ++gi) { const GD g = make_gd(Q, gi); gemm_phase(lds, g, Q, G, bx, tid); }
    }
    if constexpr (PH == 0) cg::this_grid().sync();
    else if constexpr (PH < 12) xcd_barrier(Q.barw, (volatile LAS unsigned*)(lds + LDS_BYTES - 16));
}
__global__ void __launch_bounds__(NTHREADS, 2) mega_fwd(Params P) {
    extern __shared__ __attribute__((aligned(16))) unsigned char lds_raw[];
    LAS unsigned char* lds = (LAS unsigned char*)lds_raw;
    const int G = gridDim.x, bx = blockIdx.x;
    const int vcu = (G % 8 == 0) ? (bx % 8) * (G / 8) + bx / 8 : bx;
    if (threadIdx.x == 0) { volatile LAS unsigned* st = (volatile LAS unsigned*)(lds + LDS_BYTES - 16); st[0] = 0u; st[1] = 0u; (void)xb_add(&P.barw[XB_XCNT(xb_xcc_id())], 1u); }
    __syncthreads();
    run_phase<0>(lds, vcu, G, bx); run_phase<1>(lds, vcu, G, bx); run_phase<2>(lds, vcu, G, bx); run_phase<3>(lds, vcu, G, bx);
    run_phase<4>(lds, vcu, G, bx); run_phase<5>(lds, vcu, G, bx); run_phase<6>(lds, vcu, G, bx); run_phase<7>(lds, vcu, G, bx);
    run_phase<8>(lds, vcu, G, bx); run_phase<9>(lds, vcu, G, bx); run_phase<10>(lds, vcu, G, bx); run_phase<11>(lds, vcu, G, bx);
    run_phase<12>(lds, vcu, G, bx);
}

extern "C" void kernel_launch(void* const* d_in, const int* in_sizes, int n_in, void* d_out, int out_size, void* d_ws, size_t ws_size, hipStream_t stream) {
    static int grid = 0;
    if (grid == 0) {
        int dev = 0, cus = 0, per_cu = 0;
        (void)hipGetDevice(&dev); (void)hipDeviceGetAttribute(&cus, hipDeviceAttributeMultiprocessorCount, dev);
        (void)hipFuncSetAttribute((const void*)mega_fwd, hipFuncAttributeMaxDynamicSharedMemorySize, LDS_BYTES);
        (void)hipOccupancyMaxActiveBlocksPerMultiprocessor(&per_cu, (const void*)mega_fwd, NTHREADS, LDS_BYTES);
        if (per_cu < 1) per_cu = 1;
        grid = (cus > 0 ? cus : 256) * per_cu;
        if (ws_size < 976 * MiB) fprintf(stderr, "kernel_launch: workspace too small (%zu)\n", ws_size);
    }
    Params P{};
    for (int i = 0; i < 34; ++i) P.in[i] = (const float*)d_in[i];
    P.out = (float*)d_out;
    char* ws = (char*)d_ws; size_t off = 0;
    auto take = [&](size_t bytes) { char* p = ws + off; off += (bytes + 255) & ~(size_t)255; return p; };
    P.W13T = (bf16_t*)take(5632 * 1024 * 2); P.W2T = (bf16_t*)take(1024 * 2816 * 2); P.WinT = (bf16_t*)take(2048 * 1024 * 2); P.GluT = (bf16_t*)take(512 * 512 * 2);
    P.WoutT = (bf16_t*)take(1024 * 1024 * 2); P.WqN = (bf16_t*)take(1024 * 1024 * 2); P.WkvT = (bf16_t*)take(2048 * 1024 * 2); P.WoT = (bf16_t*)take(1024 * 1024 * 2);
    P.W13bT = (bf16_t*)take(5632 * 1024 * 2); P.W2bT = (bf16_t*)take(1024 * 2816 * 2);
    P.memb = (bf16_t*)take(5120 * 1024 * 2); P.kvm = (bf16_t*)take(5120 * 2048 * 2); P.Wqk = (bf16_t*)take((size_t)20 * 1024 * 1024 * 2); P.VWo = (bf16_t*)take((size_t)20 * 1024 * 1024 * 2);
    P.Mcat = (bf16_t*)take((size_t)32 * 512 * 768 * 2); P.Pcat = (bf16_t*)take((size_t)32 * 256 * 512 * 2);
    P.KT = (float*)take((size_t)32 * 2 * 32 * 256 * 4); P.stats = (float*)take((size_t)4 * NTOK * 2 * 4);
    P.cs_in = (float*)take(2 * 2048 * 4); P.cs_f2 = (float*)take(2 * 5632 * 4); P.cs_m = (float*)take(2 * 20 * 1024 * 4); P.btab = (float*)take(4 * 260 * 4); P.TA = (float*)take((size_t)64 * 33 * 64 * 8); P.TC = (float*)take((size_t)64 * 64 * 8); P.barw = (unsigned*)take(XCD_BAR_WORDS * 4 + 384 * 4); P.pcnt = P.barw + XCD_BAR_WORDS;
    P.SB = ws + 208 * MiB; P.SC = P.SB + 192 * MiB; P.SA = P.SC + 384 * MiB;
    P.ph_lo = 0; P.ph_hi = 16;
    (void)hipMemsetAsync(P.barw, 0, XCD_BAR_WORDS * 4 + 384 * 4, stream);
    void* args[] = {&P};
    hipError_t e = hipLaunchCooperativeKernel((const void*)mega_fwd, dim3(grid), dim3(NTHREADS), args, LDS_BYTES, stream);
    if (e != hipSuccess) fprintf(stderr, "cooperative launch failed: %s (grid %d)\n", hipGetErrorString(e), grid);
}
```

```cpp
#include <hip/hip_runtime.h>
#include <hip/hip_cooperative_groups.h>
#include <cstdint>
#include <cstdio>
namespace cg = cooperative_groups;

#define LAS __attribute__((address_space(3)))
typedef unsigned short bf16_t;
typedef short bf16x8 __attribute__((ext_vector_type(8)));
typedef short s16x4 __attribute__((ext_vector_type(4)));
typedef float f32x4 __attribute__((ext_vector_type(4)));
typedef float f32x2 __attribute__((ext_vector_type(2)));
typedef float f32x16 __attribute__((ext_vector_type(16)));
typedef unsigned u32x4 __attribute__((ext_vector_type(4)));
typedef unsigned u32x2 __attribute__((ext_vector_type(2)));
typedef __bf16 bf16x2_t __attribute__((ext_vector_type(2)));

constexpr int NTOK = 98304, NPROMPT = 32768;
constexpr float ALPHA = 1.189207115002721f;
constexpr float LOG2E = 1.4426950408889634f;
constexpr float QSCALE = 0.125f * LOG2E;
constexpr float MSCALE = 0.0625f * LOG2E;
constexpr float LN_EPS = 1e-5f;
constexpr int LDS_BYTES = 160 * 1024;
constexpr int NTHREADS = 512;

struct Params {
    const float* in[34];
    float* out;
    bf16_t *W13T, *W2T, *WinT, *GluT, *WoutT, *WqN, *WkvT, *WoT, *W13bT, *W2bT;
    bf16_t *memb, *kvm, *Wqk, *VWo, *Mcat, *Pcat;
    float *KT, *stats, *cs_in, *cs_f2, *cs_m, *btab, *TA, *TC;
    char *SB, *SC, *SA;
    unsigned* barw;
    unsigned* pcnt;
    int ph_lo, ph_hi;
};
enum { I_XP = 0, I_XS, I_MP, I_MS, I_F1W13, I_F1W2, I_G1, I_B1, I_WIN, I_DLAM, I_SUBG, I_RELB, I_LRE, I_LIM, I_LSTEP, I_BRE, I_BIM, I_CRE, I_CIM,
       I_SSMD, I_GLUW, I_GLUB, I_WOUT, I_G2, I_B2, I_WQ, I_WKV, I_WO, I_G3, I_B3, I_F2W13, I_F2W2, I_G4, I_B4 };

constexpr size_t MiB = 1u << 20;
#define BUF_XB(P)   ((bf16_t*)(P).SA)
#define BUF_H1(P)   ((bf16_t*)(P).SB)
#define BUF_Y1B(P)  ((bf16_t*)(P).out)
#define BUF_Q(P)    ((bf16_t*)(P).SB)
#define BUF_K(P)    ((bf16_t*)((P).SB + 96 * MiB))
#define BUF_VT(P)   ((bf16_t*)((P).SB + 192 * MiB))
#define BUF_ACAT(P) ((bf16_t*)((P).SB + 288 * MiB))
#define BUF_X(P)    ((float*)((P).SB + 432 * MiB))
#define BUF_CAT(P)  ((bf16_t*)(P).SA)
#define BUF_Z(P)    ((bf16_t*)(P).SB)
#define BUF_Y2(P)   ((float*)(P).SC)
#define BUF_Y2B(P)  ((bf16_t*)(P).SB)
#define BUF_PM(P)   ((bf16_t*)(P).SA)
#define BUF_Y3B(P)  ((bf16_t*)(P).SB)
#define BUF_H2(P)   ((bf16_t*)(P).SC)

__device__ __forceinline__ unsigned f2bf(float f) { unsigned u = __builtin_bit_cast(unsigned, f); return (u + 0x7fffu + ((u >> 16) & 1u)) >> 16; }
__device__ __forceinline__ unsigned pk2(float lo, float hi) { f32x2 v = {lo, hi}; bf16x2_t b = __builtin_convertvector(v, bf16x2_t); return __builtin_bit_cast(unsigned, b); }
__device__ __forceinline__ float bf2f(unsigned short b) { return __builtin_bit_cast(float, (unsigned)b << 16); }
__device__ __forceinline__ float bflo(unsigned w) { return __builtin_bit_cast(float, w << 16); }
__device__ __forceinline__ float bfhi(unsigned w) { return __builtin_bit_cast(float, w & 0xffff0000u); }
#define LDS_WAIT() asm volatile("s_waitcnt lgkmcnt(0)" ::: "memory")

__device__ __forceinline__ int seq_of_pm(int pm) { return pm < 128 ? (pm >> 5) : 4 + ((pm - 128) >> 4); }

namespace pg8 {
constexpr int BM = 256, BK = 64, HALF = 128, HTB = HALF * BK * 2, STAGE_BYTES = 8 * HTB, NXCD = 8, WGM = 4;
__device__ __forceinline__ int lds_byte(int r, int c) { const int st = (r >> 4) * 2 + (c >> 5), rr = r & 15, cc = c & 31, ob = rr * 64 + cc * 2; return st * 1024 + (ob ^ (((ob >> 9) & 1) << 5)); }
__device__ __forceinline__ void stage_rc(int b, int& R, int& C) { const int st = b / 1024, sb = b % 1024, swz = sb ^ (((sb >> 9) & 1) << 5); R = (st >> 1) * 16 + swz / 64; C = (st & 1) * 32 + (swz % 64) / 2; }
__device__ __forceinline__ int perm32(int rho) { const int n = rho >> 4, i = rho & 15; return 8 * (i >> 2) + 4 * n + (i & 3); }
struct Unit { int pm, pn, grp; };
}
enum { M_SWIGLU = 0, M_RESID, M_QKU, M_VT, M_KVMEM, M_WQK, M_VWO, M_SSM1, M_SSM3, M_GLU, M_SCORES };
struct GD {
    const char* A; const char* B;
    int lda, ldb;
    int a_s1, a_s2, b_s1, b_s2;
    int gdiv, bseq;
    int K, nM, nN, ngrp, mode, perm, stage;
};
__device__ __forceinline__ bool unit_next(const GD& g, int i, int G, int c, pg8::Unit& u) {
    using namespace pg8;
    const int per = g.nM * g.nN, nwg = per * g.ngrp;
    const long L = (long)i * G + c; if (L >= nwg) return false;
    int wgid = (int)L; { const int q = nwg / NXCD, r = nwg % NXCD, xcd = wgid % NXCD, off = wgid / NXCD; wgid = (xcd < r ? xcd * (q + 1) : r * (q + 1) + (xcd - r) * q) + off; }
    u.grp = wgid / per; const int w = wgid % per;
    const int nig = WGM * g.nN, gid = w / nig, fm = gid * WGM, gsz = (g.nM - fm) < WGM ? (g.nM - fm) : WGM;
    u.pm = fm + ((w % nig) % gsz); u.pn = (w % nig) / gsz; return true;
}
__device__ __forceinline__ const char* unit_a(const GD& g, const pg8::Unit& u) { return g.A + (long)(u.grp / g.gdiv) * g.a_s1 + (long)(u.grp % g.gdiv) * g.a_s2 + (long)u.pm * 256 * g.lda; }
__device__ __forceinline__ const char* unit_b(const GD& g, const pg8::Unit& u) { const int gb = g.bseq ? seq_of_pm(u.pm) : (u.grp / g.gdiv); return g.B + (long)gb * g.b_s1 + (long)(u.grp % g.gdiv) * g.b_s2 + (long)u.pn * 256 * g.ldb; }

__device__ __forceinline__ float silu_f(float a) { return a * __builtin_amdgcn_rcpf(1.f + __builtin_amdgcn_exp2f(-LOG2E * a)); }
__device__ __forceinline__ float sigm_f(float a) { return __builtin_amdgcn_rcpf(1.f + __builtin_amdgcn_exp2f(-LOG2E * a)); }
__device__ __forceinline__ float gelu_tanh(float y) { const float t = 0.7978845608028654f * (y + 0.044715f * y * y * y); const float e = __builtin_amdgcn_exp2f(2.f * LOG2E * t); const float th = 1.f - 2.f * __builtin_amdgcn_rcpf(e + 1.f); return 0.5f * y * (1.f + th); }
__device__ __forceinline__ void row_stat(const float* st, int row, float& mu, float& rs) { const f32x2 s = *(const f32x2*)(st + 2 * (size_t)row); mu = s.x * (1.f / 1024.f); const float var = s.y * (1.f / 1024.f) - mu * mu; rs = rsqrtf(fmaxf(var, 0.f) + LN_EPS); }

template <int MODE> __device__ __forceinline__ void perm_epi(const Params* Pk, f32x4 (&acc)[2][2][4][2], const pg8::Unit& u, int rbase, int cw) {
    asm volatile("" : "+s"(Pk)); const Params& P = *Pk;
    float mus[2][4], rss[2][4];
#pragma unroll
    for (int ai = 0; ai < 2; ++ai)
#pragma unroll
        for (int m = 0; m < 4; ++m) { mus[ai][m] = 0.f; rss[ai][m] = 1.f; if (MODE == M_QKU) row_stat(P.stats, rbase + ai * 128 + m * 16, mus[ai][m], rss[ai][m]); }
#pragma unroll
    for (int bj = 0; bj < 2; ++bj) {
        const int cc = bj * 128 + cw; const int col = u.pn * 256 + cc;
        float k1[8], k2[8];
#pragma unroll
        for (int e = 0; e < 8; ++e) { k1[e] = 0.f; k2[e] = 0.f; }
        if (MODE == M_QKU) {
#pragma unroll
            for (int e = 0; e < 8; ++e) { k1[e] = P.cs_in[col + e]; k2[e] = P.cs_in[2048 + col + e]; }
        } else if (MODE == M_VT) {
#pragma unroll
            for (int e = 0; e < 8; ++e) row_stat(P.stats, col + e, k1[e], k2[e]);
        } else if (MODE == M_SCORES) { const float* cs = P.cs_m + (size_t)seq_of_pm(u.pm) * 1024 + col;
#pragma unroll
            for (int e = 0; e < 8; ++e) { k1[e] = cs[e]; k2[e] = cs[20 * 1024 + e]; }
        } else if (MODE == M_WQK) {
#pragma unroll
            for (int e = 0; e < 8; ++e) k1[e] = P.in[I_G2][col + e] * MSCALE;
        } else if (MODE == M_GLU) {
#pragma unroll
            for (int e = 0; e < 8; ++e) k1[e] = P.in[I_GLUB][col + e];
        }
#pragma unroll
        for (int ai = 0; ai < 2; ++ai)
#pragma unroll
            for (int m = 0; m < 4; ++m) {
                const int row = rbase + ai * 128 + m * 16;
                float v[8];
#pragma unroll
                for (int n = 0; n < 2; ++n)
#pragma unroll
                    for (int r = 0; r < 4; ++r) v[n * 4 + r] = acc[ai][bj][m][n][r];
                bf16_t* dst;
                if (MODE == M_QKU) {
                    const float mu = mus[ai][m], rs = rss[ai][m];
#pragma unroll
                    for (int e = 0; e < 8; ++e) v[e] = rs * (v[e] - mu * k1[e]) + k2[e];
                    if (u.pn < 2) { dst = BUF_Q(P) + (size_t)row * 512 + col;
#pragma unroll
                        for (int e = 0; e < 8; ++e) v[e] *= QSCALE; }
                    else if (u.pn < 4) dst = BUF_K(P) + (size_t)row * 512 + (col - 512);
                    else { const int ch = col - 1024; dst = BUF_ACAT(P) + ((size_t)((ch >> 4) * 3072 + (row >> 5)) * 768 + (row & 31) * 16 + (ch & 15)); }
                } else if (MODE == M_VT) {
                    const float c1 = P.cs_in[1536 + row], c2 = P.cs_in[2048 + 1536 + row];
#pragma unroll
                    for (int e = 0; e < 8; ++e) v[e] = k2[e] * (v[e] - k1[e] * c1) + c2;
                    dst = BUF_VT(P) + (size_t)row * NTOK + col;
                } else if (MODE == M_SCORES) {
                    float mu, rs; row_stat(P.stats + 2 * (size_t)NTOK, row, mu, rs);
#pragma unroll
                    for (int e = 0; e < 8; ++e) v[e] = rs * (v[e] - mu * k1[e]) + k2[e];
                    dst = BUF_PM(P) + (size_t)row * 1024 + col;
                } else if (MODE == M_KVMEM) dst = P.kvm + (size_t)row * 2048 + col;
                else if (MODE == M_WQK) { dst = P.Wqk + (size_t)(u.grp >> 2) * 1048576 + (size_t)((u.grp & 3) * 256 + row) * 1024 + col;
#pragma unroll
                    for (int e = 0; e < 8; ++e) v[e] *= k1[e]; }
                else if (MODE == M_VWO) dst = P.VWo + (size_t)(u.grp >> 2) * 1048576 + (size_t)row * 1024 + (u.grp & 3) * 256 + col;
                else if (MODE == M_SSM3) { dst = BUF_Z(P) + (size_t)(row * 32 + (col >> 4)) * 512 + u.grp * 16 + (col & 15);
#pragma unroll
                    for (int e = 0; e < 8; ++e) v[e] = gelu_tanh(v[e]); }
                else { const u32x4 zv = *(const u32x4*)(BUF_Z(P) + (size_t)row * 512 + col); dst = BUF_CAT(P) + (size_t)row * 1024 + 512 + col;
                    v[0] = bflo(zv.x) * sigm_f(v[0] + k1[0]); v[1] = bfhi(zv.x) * sigm_f(v[1] + k1[1]); v[2] = bflo(zv.y) * sigm_f(v[2] + k1[2]); v[3] = bfhi(zv.y) * sigm_f(v[3] + k1[3]);
                    v[4] = bflo(zv.z) * sigm_f(v[4] + k1[4]); v[5] = bfhi(zv.z) * sigm_f(v[5] + k1[5]); v[6] = bflo(zv.w) * sigm_f(v[6] + k1[6]); v[7] = bfhi(zv.w) * sigm_f(v[7] + k1[7]); }
                u32x4 w; w.x = pk2(v[0], v[1]); w.y = pk2(v[2], v[3]); w.z = pk2(v[4], v[5]); w.w = pk2(v[6], v[7]);
                if (MODE == M_VT) {
                    bf16_t* g16 = BUF_VT(P) + (size_t)row * NTOK + (col & ~15); const int hi8 = (col >> 3) & 1;
                    *(u32x2*)(g16 + hi8 * 4) = (u32x2){w.x, w.y}; *(u32x2*)(g16 + 8 + hi8 * 4) = (u32x2){w.z, w.w};
                } else *(u32x4*)dst = w;
            }
    }
}
__device__ __forceinline__ void gemm_epilogue(const GD& g, const Params* Pk, f32x4 (&acc)[2][2][4][2], const pg8::Unit& u, int wr, int wc, int fr, int fq, LAS unsigned char* xs) {
#if defined(EPI_ONLY)
    const int mode = (g.mode == EPI_ONLY) ? EPI_ONLY : 99; const int stage = g.stage;
#elif defined(EPI_SKIP)
    const int mode = (g.mode == EPI_SKIP || g.mode == EPI_SKIP2) ? 99 : g.mode; const int stage = g.stage;
#else
    const int mode = g.mode, stage = g.stage;
#endif
    const int rbase = u.pm * 256 + wr * 64 + fr;
    const int cw = wc * 32 + 8 * fq;
    const int cwn = wc * 32 + 4 * fq;
    if (mode == M_SWIGLU) {
        asm volatile("" : "+s"(Pk)); const Params& P = *Pk;
        const bool fold = stage == 4;
        bf16_t* O = fold ? BUF_H2(P) : BUF_H1(P);
        const float* st = P.stats + 4 * (size_t)NTOK;
        const float* cs = P.cs_f2 + u.pn * 256 + cw;
        f32x4 c1a[2], c2a[2], c1b[2], c2b[2];
#pragma unroll
        for (int n = 0; n < 2; ++n) { if (fold) { c1a[n] = *(const f32x4*)(cs + 4 * n); c2a[n] = *(const f32x4*)(cs + 5632 + 4 * n); c1b[n] = *(const f32x4*)(cs + 128 + 4 * n); c2b[n] = *(const f32x4*)(cs + 5632 + 128 + 4 * n); }
            else { c1a[n] = c2a[n] = c1b[n] = c2b[n] = (f32x4){0.f, 0.f, 0.f, 0.f}; } }
        float mus[2][4], rss[2][4];
#pragma unroll
        for (int ai = 0; ai < 2; ++ai)
#pragma unroll
            for (int m = 0; m < 4; ++m) { mus[ai][m] = 0.f; rss[ai][m] = 1.f; if (fold) row_stat(st, rbase + ai * 128 + m * 16, mus[ai][m], rss[ai][m]); }
#pragma unroll
        for (int ai = 0; ai < 2; ++ai)
#pragma unroll
            for (int m = 0; m < 4; ++m) {
                const int row = rbase + ai * 128 + m * 16; const float mu = mus[ai][m], rs = rss[ai][m];
                unsigned w[4];
#pragma unroll
                for (int n = 0; n < 2; ++n) {
                    float hv[4];
#pragma unroll
                    for (int r = 0; r < 4; ++r) { float a = acc[ai][0][m][n][r], b = acc[ai][1][m][n][r];
                        if (fold) { a = rs * (a - mu * c1a[n][r]) + c2a[n][r]; b = rs * (b - mu * c1b[n][r]) + c2b[n][r]; }
                        hv[r] = silu_f(a) * b; }
                    w[2 * n] = pk2(hv[0], hv[1]); w[2 * n + 1] = pk2(hv[2], hv[3]); }
                *(u32x4*)(O + (size_t)row * 2816 + u.pn * 128 + cw) = (u32x4){w[0], w[1], w[2], w[3]};
            }
    } else if (mode == M_RESID) {
        asm volatile("" : "+s"(Pk)); const Params& P = *Pk;
        const float scale = (stage == 1 || stage == 4) ? 0.5f : 1.f;
        if (stage == 4) {
            const bf16_t* prevb = BUF_Y3B(P); const float* pst = P.stats + 4 * (size_t)NTOK; const float* pg = P.in[I_G3]; const float* pb = P.in[I_B3]; float* st4 = P.stats + 6 * (size_t)NTOK;
            f32x4 gv[2][2], bv[2][2];
#pragma unroll
            for (int bj = 0; bj < 2; ++bj)
#pragma unroll
                for (int n = 0; n < 2; ++n) { const int c0 = u.pn * 256 + bj * 128 + n * 16 + cwn; gv[bj][n] = *(const f32x4*)(pg + c0); bv[bj][n] = *(const f32x4*)(pb + c0); }
#pragma unroll
            for (int ai = 0; ai < 2; ++ai)
#pragma unroll
                for (int m = 0; m < 4; ++m) {
                    const int row = rbase + ai * 128 + m * 16; float mu, rs; row_stat(pst, row, mu, rs);
                    float s = 0.f, ss = 0.f;
#pragma unroll
                    for (int bj = 0; bj < 2; ++bj)
#pragma unroll
                        for (int n = 0; n < 2; ++n) { const int c0 = u.pn * 256 + bj * 128 + n * 16 + cwn; const size_t off = (size_t)row * 1024 + c0;
                            const u32x2 w = *(const u32x2*)(prevb + off); f32x4 xp = (f32x4){bflo(w.x), bfhi(w.x), bflo(w.y), bfhi(w.y)};
                            xp = (xp - mu) * rs * gv[bj][n] + bv[bj][n];
                            const f32x4 y = xp * ALPHA + acc[ai][bj][m][n] * 0.5f; acc[ai][bj][m][n] = y;
                            s += (y[0] + y[1]) + (y[2] + y[3]); ss += (y[0] * y[0] + y[1] * y[1]) + (y[2] * y[2] + y[3] * y[3]); }
                    s += __shfl_xor(s, 16); s += __shfl_xor(s, 32); ss += __shfl_xor(ss, 16); ss += __shfl_xor(ss, 32);
                    if (fq == 0) { unsafeAtomicAdd(st4 + 2 * (size_t)row, s); unsafeAtomicAdd(st4 + 2 * (size_t)row + 1, ss); }
                }
            asm volatile("s_waitcnt vmcnt(0)" ::: "memory");
            unsigned* pc = P.pcnt + u.pm;
            if ((fr | fq) == 0) (void)__hip_atomic_fetch_add(pc, 1u, __ATOMIC_RELAXED, __HIP_MEMORY_SCOPE_AGENT);
            { unsigned sp = 0; while ((unsigned)__builtin_amdgcn_readfirstlane(__hip_atomic_load(pc, __ATOMIC_RELAXED, __HIP_MEMORY_SCOPE_AGENT)) < 32u) { __builtin_amdgcn_s_sleep(2); if (++sp > (1u << 22)) break; } }
            asm volatile("" ::: "memory");
            float* yo = P.out; const float* g4 = P.in[I_G4]; const float* b4 = P.in[I_B4];
#pragma unroll
            for (int bj = 0; bj < 2; ++bj)
#pragma unroll
                for (int n = 0; n < 2; ++n) { const int c0 = u.pn * 256 + bj * 128 + n * 16 + cwn; gv[bj][n] = *(const f32x4*)(g4 + c0); bv[bj][n] = *(const f32x4*)(b4 + c0); }
#pragma unroll
            for (int ai = 0; ai < 2; ++ai)
#pragma unroll
                for (int m = 0; m < 4; ++m) {
                    const int row = rbase + ai * 128 + m * 16;
                    const float sm = __hip_atomic_load(st4 + 2 * (size_t)row, __ATOMIC_RELAXED, __HIP_MEMORY_SCOPE_AGENT), sq = __hip_atomic_load(st4 + 2 * (size_t)row + 1, __ATOMIC_RELAXED, __HIP_MEMORY_SCOPE_AGENT);
                    const float mu = sm * (1.f / 1024.f); const float rs = rsqrtf(fmaxf(sq * (1.f / 1024.f) - mu * mu, 0.f) + LN_EPS);
#pragma unroll
                    for (int bj = 0; bj < 2; ++bj)
#pragma unroll
                        for (int n = 0; n < 2; ++n) { const int c0 = u.pn * 256 + bj * 128 + n * 16 + cwn;
                            *(f32x4*)(yo + (size_t)row * 1024 + c0) = (acc[ai][bj][m][n] - mu) * rs * gv[bj][n] + bv[bj][n]; }
                }
        } else {
        const float* prevf = nullptr; const bf16_t* prevb = nullptr; const float* pst = nullptr; const float* pg = nullptr; const float* pb = nullptr; float* yo = nullptr; bf16_t* yb = nullptr; float* ost = nullptr;
        if (stage == 1) { prevf = (u.pm < 128) ? P.in[I_XP] : (P.in[I_XS] - (size_t)NPROMPT * 1024); yb = BUF_Y1B(P); ost = P.stats; }
        else if (stage == 2) { prevb = BUF_Y1B(P); pst = P.stats; pg = P.in[I_G1]; pb = P.in[I_B1]; yb = BUF_Y2B(P); ost = P.stats + 2 * (size_t)NTOK; }
        else if (stage == 3) { prevb = BUF_Y2B(P); pst = P.stats + 2 * (size_t)NTOK; pg = P.in[I_G2]; pb = P.in[I_B2]; yb = BUF_Y3B(P); ost = P.stats + 4 * (size_t)NTOK; }
        else { prevb = BUF_Y3B(P); pst = P.stats + 4 * (size_t)NTOK; pg = P.in[I_G3]; pb = P.in[I_B3]; yo = P.out; }
        f32x4 gv[2][2], bv[2][2];
#pragma unroll
        for (int bj = 0; bj < 2; ++bj)
#pragma unroll
            for (int n = 0; n < 2; ++n) { const int c0 = u.pn * 256 + bj * 128 + n * 16 + cwn; if (pg) { gv[bj][n] = *(const f32x4*)(pg + c0); bv[bj][n] = *(const f32x4*)(pb + c0); } else { gv[bj][n] = (f32x4){1.f, 1.f, 1.f, 1.f}; bv[bj][n] = (f32x4){0.f, 0.f, 0.f, 0.f}; } }
#pragma unroll
        for (int ai = 0; ai < 2; ++ai) {
#pragma unroll
            for (int m = 0; m < 4; ++m) {
                const int row = rbase + ai * 128 + m * 16; float mu = 0.f, rs = 1.f; if (pst) row_stat(pst, row, mu, rs);
                float s = 0.f, ss = 0.f;
#pragma unroll
                for (int bj = 0; bj < 2; ++bj)
#pragma unroll
                    for (int n = 0; n < 2; ++n) { const int c0 = u.pn * 256 + bj * 128 + n * 16 + cwn; const size_t off = (size_t)row * 1024 + c0;
                        f32x4 xp;
                        if (prevf) xp = *(const f32x4*)(prevf + off);
                        else { const u32x2 w = *(const u32x2*)(prevb + off); xp = (f32x4){bflo(w.x), bfhi(w.x), bflo(w.y), bfhi(w.y)}; }
                        if (pg) xp = (xp - mu) * rs * gv[bj][n] + bv[bj][n];
                        const f32x4 y = xp * ALPHA + acc[ai][bj][m][n] * scale;
                        if (yo) *(f32x4*)(yo + off) = y;
                        if (yb) { u32x2 w; w.x = pk2(y[0], y[1]); w.y = pk2(y[2], y[3]); *(u32x2*)(yb + off) = w; }
                        s += (y[0] + y[1]) + (y[2] + y[3]); ss += (y[0] * y[0] + y[1] * y[1]) + (y[2] * y[2] + y[3] * y[3]); }
                if (ost) { s += __shfl_xor(s, 16); s += __shfl_xor(s, 32); ss += __shfl_xor(ss, 16); ss += __shfl_xor(ss, 32);
                    if (fq == 0) { unsafeAtomicAdd(ost + 2 * (size_t)row, s); unsafeAtomicAdd(ost + 2 * (size_t)row + 1, ss); } }
            }
        }
        }
    } else if (mode == M_SSM1) {
        asm volatile("" : "+s"(Pk)); const Params& P = *Pk;
        float* X = BUF_X(P) + (size_t)u.grp * 3072 * 256;
#pragma unroll
        for (int ai = 0; ai < 2; ++ai)
#pragma unroll
            for (int m = 0; m < 4; ++m) { const int row = rbase + ai * 128 + m * 16;
#pragma unroll
                for (int bj = 0; bj < 2; ++bj)
#pragma unroll
                    for (int n = 0; n < 2; ++n) *(f32x4*)(X + (size_t)row * 256 + bj * 128 + n * 16 + cwn) = acc[ai][bj][m][n]; }
    } else if (mode == M_QKU) perm_epi<M_QKU>(Pk, acc, u, rbase, cw);
    else if (mode == M_VT) perm_epi<M_VT>(Pk, acc, u, rbase, cw);
    else if (mode == M_KVMEM) perm_epi<M_KVMEM>(Pk, acc, u, rbase, cw);
    else if (mode == M_WQK) perm_epi<M_WQK>(Pk, acc, u, rbase, cw);
    else if (mode == M_VWO) perm_epi<M_VWO>(Pk, acc, u, rbase, cw);
    else if (mode == M_SSM3) perm_epi<M_SSM3>(Pk, acc, u, rbase, cw);
    else if (mode == M_GLU) perm_epi<M_GLU>(Pk, acc, u, rbase, cw);
    else if (mode == M_SCORES) {
        asm volatile("" : "+s"(Pk)); const Params& P = *Pk;
        const float* st = P.stats + 2 * (size_t)NTOK;
        const float* cs = P.cs_m + (size_t)seq_of_pm(u.pm) * 1024 + u.pn * 256 + cw;
        LAS f32x2* XS = (LAS f32x2*)xs;
        f32x4 k1[2][2], k2[2][2];
#pragma unroll
        for (int bj = 0; bj < 2; ++bj)
#pragma unroll
            for (int n = 0; n < 2; ++n) { k1[bj][n] = *(const f32x4*)(cs + bj * 128 + n * 4); k2[bj][n] = *(const f32x4*)(cs + 20 * 1024 + bj * 128 + n * 4); }
        float mw[2][4];
#pragma unroll
        for (int ai = 0; ai < 2; ++ai)
#pragma unroll
            for (int m = 0; m < 4; ++m) {
                const int row = rbase + ai * 128 + m * 16; float mu, rs; row_stat(st, row, mu, rs);
                float mx = -1e30f;
#pragma unroll
                for (int bj = 0; bj < 2; ++bj)
#pragma unroll
                    for (int n = 0; n < 2; ++n)
#pragma unroll
                        for (int r = 0; r < 4; ++r) { const float sv = rs * (acc[ai][bj][m][n][r] - mu * k1[bj][n][r]) + k2[bj][n][r]; acc[ai][bj][m][n][r] = sv; mx = fmaxf(mx, sv); }
                mx = fmaxf(mx, __shfl_xor(mx, 16)); mx = fmaxf(mx, __shfl_xor(mx, 32));
                float l = 0.f;
#pragma unroll
                for (int bj = 0; bj < 2; ++bj)
#pragma unroll
                    for (int n = 0; n < 2; ++n)
#pragma unroll
                        for (int r = 0; r < 4; ++r) { const float ev = __builtin_amdgcn_exp2f(acc[ai][bj][m][n][r] - mx); acc[ai][bj][m][n][r] = ev; l += ev; }
                l += __shfl_xor(l, 16); l += __shfl_xor(l, 32);
                mw[ai][m] = mx;
                if (fq == 0) XS[(ai * 128 + wr * 64 + m * 16 + fr) * 4 + wc] = (f32x2){mx, l};
            }
        LDS_WAIT(); __builtin_amdgcn_s_barrier(); asm volatile("" ::: "memory");
#pragma unroll
        for (int ai = 0; ai < 2; ++ai)
#pragma unroll
            for (int m = 0; m < 4; ++m) {
                const int rl = ai * 128 + wr * 64 + m * 16 + fr; const int row = u.pm * 256 + rl;
                const f32x2 a = XS[rl * 4 + 0], b = XS[rl * 4 + 1], c = XS[rl * 4 + 2], d = XS[rl * 4 + 3];
                const float M = fmaxf(fmaxf(a.x, b.x), fmaxf(c.x, d.x));
                const float Lt = a.y * __builtin_amdgcn_exp2f(a.x - M) + b.y * __builtin_amdgcn_exp2f(b.x - M) + c.y * __builtin_amdgcn_exp2f(c.x - M) + d.y * __builtin_amdgcn_exp2f(d.x - M);
                const float f = __builtin_amdgcn_exp2f(mw[ai][m] - M) * __builtin_amdgcn_rcpf(Lt);
#pragma unroll
                for (int bj = 0; bj < 2; ++bj) { const f32x4 v0 = acc[ai][bj][m][0] * f, v1 = acc[ai][bj][m][1] * f;
                    u32x4 w; w.x = pk2(v0[0], v0[1]); w.y = pk2(v0[2], v0[3]); w.z = pk2(v1[0], v1[1]); w.w = pk2(v1[2], v1[3]);
                    *(u32x4*)(BUF_PM(P) + (size_t)row * 1024 + u.pn * 256 + bj * 128 + cw) = w; }
            }
    }
}

__device__ __forceinline__ void gemm_phase(LAS unsigned char* lds, const GD& g, const Params& P, int G, int c, int tid) {
    using namespace pg8;
    const int wid = __builtin_amdgcn_readfirstlane(tid >> 6), lane = tid & 63, wr = wid >> 2, wc = wid & 3, fr = lane & 15, fq = lane >> 4;
    const int K = g.K, nt = K / BK;
    unsigned voffA, voffB;
    { int R, C; stage_rc(tid * 16, R, C); const int Rb = g.perm ? ((R & ~31) + perm32(R & 31)) : R;
        voffA = (unsigned)(R * g.lda + C * 2); voffB = (unsigned)(Rb * g.ldb + C * 2); }
    const int q64A = 64 * g.lda, q64B = 64 * g.ldb;
    const size_t kstep = (size_t)(BK * 2);
    const size_t hstepA = (size_t)HALF * g.lda, hstepB = (size_t)HALF * g.ldb;
    const unsigned ldsw = (unsigned)wid * 1024u;
    const int aoff = lds_byte(wr * 64 + fr, fq * 8), boff = lds_byte(wc * 32 + fr, fq * 8);
#define PG8_SA(b, h) (((b) * 2 + (h)) * HTB)
#define PG8_SB(b, h) ((4 + (b) * 2 + (h)) * HTB)
#define PG8_STAGE(bufoff, gbase, X) do { _Pragma("unroll") for (int _i = 0; _i < 2; ++_i) \
        __builtin_amdgcn_global_load_lds((const unsigned*)((const char*)(gbase) + (size_t)(_i * q64##X) + (voff##X)), (LAS unsigned*)(lds + (bufoff) + ldsw + _i * 8192), 16, 0, 0); } while (0)
#define PG8_LDA(dst, b, h) do { _Pragma("unroll") for (int m = 0; m < 4; ++m) _Pragma("unroll") for (int k = 0; k < 2; ++k) dst[m][k] = *(const LAS bf16x8*)(lds + PG8_SA(b, h) + aoff + m * 2048 + k * 1024); } while (0)
#define PG8_LDB(dst, b, h) do { _Pragma("unroll") for (int n = 0; n < 2; ++n) _Pragma("unroll") for (int k = 0; k < 2; ++k) dst[n][k] = *(const LAS bf16x8*)(lds + PG8_SB(b, h) + boff + n * 2048 + k * 1024); } while (0)
#define PG8_MMA(ai, bj, At, Bt) do { __builtin_amdgcn_s_setprio(1); _Pragma("unroll") for (int m = 0; m < 4; ++m) _Pragma("unroll") for (int n = 0; n < 2; ++n) _Pragma("unroll") for (int k = 0; k < 2; ++k) \
        acc[ai][bj][m][n] = __builtin_amdgcn_mfma_f32_16x16x32_bf16(Bt[n][k], At[m][k], acc[ai][bj][m][n], 0, 0, 0); __builtin_amdgcn_s_setprio(0); } while (0)
#define PG8_WAIT_V(n) asm volatile("s_waitcnt vmcnt(" #n ")" ::: "memory")
#define PG8_WAIT_L(n) asm volatile("s_waitcnt lgkmcnt(" #n ")" ::: "memory")
#define PG8_BAR __builtin_amdgcn_s_barrier()
#define PG8_SCHED __builtin_amdgcn_sched_barrier(0)
    LAS int* utab = (LAS int*)(lds + STAGE_BYTES + 8192);
    int nun;
    { const int nwg = g.nM * g.nN * g.ngrp; nun = (nwg > c) ? (nwg - 1 - c) / G + 1 : 0; if (nun > 63) nun = 63; }
    for (int i = tid; i < nun; i += NTHREADS) { Unit u; unit_next(g, i, G, c, u); const unsigned long long pa = (unsigned long long)unit_a(g, u), pb = (unsigned long long)unit_b(g, u);
        utab[i * 8 + 0] = (int)(unsigned)pa; utab[i * 8 + 1] = (int)(unsigned)(pa >> 32); utab[i * 8 + 2] = (int)(unsigned)pb; utab[i * 8 + 3] = (int)(unsigned)(pb >> 32); utab[i * 8 + 4] = u.pm; utab[i * 8 + 5] = u.pn; utab[i * 8 + 6] = u.grp; }
    __syncthreads();
    if (nun == 0) return;
#define UT(i, k) __builtin_amdgcn_readfirstlane(utab[(i) * 8 + (k)])
#define UPTR(i, k) ((const char*)(((unsigned long long)(unsigned)UT(i, k)) | ((unsigned long long)(unsigned)UT(i, (k) + 1) << 32)))
    Unit cur; int ui = 0;
    cur.pm = UT(0, 4); cur.pn = UT(0, 5); cur.grp = UT(0, 6);
    f32x4 acc[2][2][4][2];
#pragma unroll
    for (int a = 0; a < 2; ++a)
#pragma unroll
        for (int b = 0; b < 2; ++b)
#pragma unroll
            for (int m = 0; m < 4; ++m)
#pragma unroll
                for (int n = 0; n < 2; ++n) acc[a][b][m][n] = (f32x4){0.f, 0.f, 0.f, 0.f};
    bf16x8 At[4][2], B0[2][2], B1[2][2];
    const char* cA = UPTR(0, 0); const char* cB = UPTR(0, 2);
    PG8_STAGE(PG8_SB(0, 0), cB, B); PG8_STAGE(PG8_SB(0, 1), cB + hstepB, B); PG8_STAGE(PG8_SA(0, 0), cA, A); PG8_STAGE(PG8_SA(0, 1), cA + hstepA, A);
    if (wr == 1) PG8_BAR;
    PG8_WAIT_V(2); PG8_BAR;
    PG8_STAGE(PG8_SB(1, 0), cB + kstep, B); PG8_STAGE(PG8_SA(1, 0), cA + kstep, A); PG8_STAGE(PG8_SB(1, 1), cB + hstepB + kstep, B);
    PG8_WAIT_V(6); PG8_BAR;
    for (;;) {
        const bool has_next = (ui + 1 < nun);
        const char* nA = has_next ? UPTR(ui + 1, 0) : cA; const char* nB = has_next ? UPTR(ui + 1, 2) : cB;
        for (int t = 0; t < nt; t += 2) {
            const bool last = (t == nt - 2);
            const char* a1 = cA + (size_t)(t + 1) * kstep;
            const char* a2 = last ? nA : cA + (size_t)(t + 2) * kstep; const char* b2 = last ? nB : cB + (size_t)(t + 2) * kstep;
            const char* a3 = a2 + kstep; const char* b3 = b2 + kstep;
            PG8_LDB(B0, 0, 0); PG8_LDB(B1, 0, 1); PG8_SCHED; PG8_LDA(At, 0, 0); PG8_STAGE(PG8_SA(1, 1), a1 + hstepA, A);
            PG8_WAIT_V(8); PG8_WAIT_L(0); PG8_BAR; PG8_MMA(0, 0, At, B0); PG8_MMA(0, 1, At, B1); PG8_BAR; PG8_SCHED;
            PG8_LDA(At, 0, 1); PG8_STAGE(PG8_SB(0, 0), b2, B); PG8_STAGE(PG8_SB(0, 1), b2 + hstepB, B); PG8_STAGE(PG8_SA(0, 0), a2, A);
            PG8_WAIT_V(8); PG8_WAIT_L(0); PG8_BAR; PG8_MMA(1, 0, At, B0); PG8_MMA(1, 1, At, B1); PG8_BAR; PG8_SCHED;
            PG8_LDB(B0, 1, 0); PG8_LDB(B1, 1, 1); PG8_SCHED; PG8_LDA(At, 1, 0); PG8_STAGE(PG8_SA(0, 1), a2 + hstepA, A);
            PG8_WAIT_V(8); PG8_WAIT_L(0); PG8_BAR; PG8_MMA(0, 0, At, B0); PG8_MMA(0, 1, At, B1); PG8_BAR; PG8_SCHED;
            PG8_LDA(At, 1, 1); PG8_STAGE(PG8_SB(1, 0), b3, B); PG8_STAGE(PG8_SB(1, 1), b3 + hstepB, B); PG8_STAGE(PG8_SA(1, 0), a3, A);
            PG8_WAIT_V(8); PG8_WAIT_L(0); PG8_BAR; PG8_MMA(1, 0, At, B0); PG8_MMA(1, 1, At, B1); PG8_BAR; PG8_SCHED;
        }
        if (wr == 0) PG8_BAR;
        { const Params* Pk = (const Params*)__builtin_amdgcn_kernarg_segment_ptr(); asm volatile("" : "+s"(Pk));
          gemm_epilogue(g, Pk, acc, cur, wr, wc, fr, fq, lds + STAGE_BYTES); }
        if (!has_next) break;
#pragma unroll
        for (int a = 0; a < 2; ++a)
#pragma unroll
            for (int b = 0; b < 2; ++b)
#pragma unroll
                for (int m = 0; m < 4; ++m)
#pragma unroll
                    for (int n = 0; n < 2; ++n) acc[a][b][m][n] = (f32x4){0.f, 0.f, 0.f, 0.f};
        ++ui; cur.pm = UT(ui, 4); cur.pn = UT(ui, 5); cur.grp = UT(ui, 6); cA = nA; cB = nB;
        if (wr == 1) PG8_BAR;
    }
    PG8_WAIT_V(0);
    PG8_BAR;
#undef PG8_SA
#undef PG8_SB
#undef PG8_STAGE
#undef PG8_LDA
#undef PG8_LDB
#undef PG8_MMA
#undef PG8_WAIT_V
#undef PG8_WAIT_L
#undef PG8_BAR
#undef PG8_SCHED
#undef UT
#undef UPTR
}

__device__ __forceinline__ double reduce_2pi(double a) { return a - 6.283185307179586 * __builtin_rint(a * 0.15915494309189535); }
__device__ __forceinline__ f32x2 cpow_f(double lr, double li, int n) {
    const float mag = expf((float)((double)n * lr));
    const float ar = (float)reduce_2pi((double)n * li);
    return (f32x2){mag * cosf(ar), mag * sinf(ar)};
}
struct SsmC { double lr, li; float cre, cim; };
__device__ __forceinline__ SsmC ssm_consts(const Params& P, int dir, int g, int p) {
    const int idx = (dir * 32 + g) * 64 + p;
    const float lre = P.in[I_LRE][idx], lim = P.in[I_LIM][idx];
    const float step = expf(P.in[I_LSTEP][dir * 32 + g]);
    SsmC r; r.lr = (double)lre * (double)step; r.li = (double)lim * (double)step;
    const float yr = (float)reduce_2pi(r.li); const float s = sinf(yr), c = cosf(yr), s2 = sinf(0.5f * yr);
    const float em1 = expm1f((float)r.lr);
    const float are = em1 * c - 2.f * s2 * s2, aim = (em1 + 1.f) * s;
    const float den = 1.f / (lre * lre + lim * lim);
    r.cre = (are * lre + aim * lim) * den; r.cim = (aim * lre - are * lim) * den;
    return r;
}
__device__ __forceinline__ f32x2 cmul(f32x2 a, f32x2 b) { return (f32x2){a.x * b.x - a.y * b.y, a.x * b.y + a.y * b.x}; }

__device__ __forceinline__ int rel_bucket(int rel) {
    const int n = rel < 0 ? -rel : rel; int b;
    if (n < 8) b = n; else if (n < 12) b = 8; else if (n < 16) b = 9; else if (n < 23) b = 10; else if (n < 32) b = 11; else if (n < 46) b = 12; else if (n < 64) b = 13; else if (n < 91) b = 14; else b = 15;
    return b + (rel > 0 ? 16 : 0);
}

__device__ __forceinline__ void tr_item(const float* W, int K, int N, bf16_t* WT, int maptype, const float* gain, LAS float* scr, int item, int lane) {
    const int nblk = N / 32, kb = item / nblk, nb = item % nblk, k0 = 64 * kb, n0 = 32 * nb;
#pragma unroll 8
    for (int i = 0; i < 32; ++i) { const int kk = 2 * i + (lane >> 5); float v = W[(size_t)(k0 + kk) * N + n0 + (lane & 31)]; if (gain) v *= gain[k0 + kk]; scr[kk * 33 + (lane & 31)] = v; }
    LDS_WAIT();
    int o0 = n0;
    if (maptype == 1) o0 = (n0 < 2816) ? ((n0 / 128) * 256 + (n0 % 128)) : (((n0 - 2816) / 128) * 256 + 128 + ((n0 - 2816) % 128));
    else if (maptype == 2) o0 = (n0 < 1024) ? n0 : (n0 < 1536 ? 1536 + (n0 - 1024) : 1024 + (n0 - 1536));
    const int c = lane & 7;
#pragma unroll
    for (int j = 0; j < 4; ++j) { const int n = (lane >> 3) + 8 * j; const LAS float* s = scr + (8 * c) * 33 + n;
        u32x4 o; o.x = pk2(s[0 * 33], s[1 * 33]); o.y = pk2(s[2 * 33], s[3 * 33]); o.z = pk2(s[4 * 33], s[5 * 33]); o.w = pk2(s[6 * 33], s[7 * 33]);
        *(u32x4*)(WT + (size_t)(o0 + n) * K + k0 + 8 * c) = o; }
    LDS_WAIT();
}
__device__ __forceinline__ void cvt_range(const float* src, bf16_t* dst, size_t n4, size_t gt, size_t ngt) {
    for (size_t i = gt; i < n4; i += ngt) { const f32x4 v = *(const f32x4*)(src + 4 * i); u32x2 w; w.x = pk2(v[0], v[1]); w.y = pk2(v[2], v[3]); *(u32x2*)(dst + 4 * i) = w; }
}
__device__ __forceinline__ void prep_a(const Params& P, LAS unsigned char* lds, int vcu, int G, int tid) {
    const int lane = tid & 63, wave = tid >> 6;
    const int gw = vcu * 8 + wave, NGW = G * 8; const size_t gt = (size_t)vcu * NTHREADS + tid, ngt = (size_t)G * NTHREADS;
    LAS float* scr = (LAS float*)(lds + wave * 16384);
#pragma unroll 1
    for (int mi = 0; mi < 9; ++mi) {
        const Params* Pm = (const Params*)__builtin_amdgcn_kernarg_segment_ptr(); asm volatile("" : "+s"(Pm));
        const float* W; bf16_t* WT; int K = 1024, N = 1024, mt = 0; const float* gain = nullptr;
        switch (mi) {
        case 0: W = Pm->in[I_F1W13]; WT = Pm->W13T; N = 5632; mt = 1; break;
        case 1: W = Pm->in[I_F1W2]; WT = Pm->W2T; K = 2816; break;
        case 2: W = Pm->in[I_WIN]; WT = Pm->WinT; N = 2048; mt = 2; gain = Pm->in[I_G1]; break;
        case 3: W = Pm->in[I_GLUW]; WT = Pm->GluT; K = 512; N = 512; break;
        case 4: W = Pm->in[I_WOUT]; WT = Pm->WoutT; break;
        case 5: W = Pm->in[I_WKV]; WT = Pm->WkvT; N = 2048; break;
        case 6: W = Pm->in[I_WO]; WT = Pm->WoT; break;
        case 7: W = Pm->in[I_F2W13]; WT = Pm->W13bT; N = 5632; mt = 1; gain = Pm->in[I_G3]; break;
        default: W = Pm->in[I_F2W2]; WT = Pm->W2bT; K = 2816; break;
        }
        const int tot = (K / 64) * (N / 32);
        for (int it = gw; it < tot; it += NGW) tr_item(W, K, N, WT, mt, gain, scr, it, lane);
    }
    { const Params* Pm = (const Params*)__builtin_amdgcn_kernarg_segment_ptr(); asm volatile("" : "+s"(Pm)); }
    asm volatile("" ::: "memory");
    cvt_range(P.in[I_XP], BUF_XB(P), (size_t)NPROMPT * 256, gt, ngt);
    cvt_range(P.in[I_XS], BUF_XB(P) + (size_t)NPROMPT * 1024, (size_t)(NTOK - NPROMPT) * 256, gt, ngt);
    cvt_range(P.in[I_MP], P.memb, (size_t)4 * 256 * 256, gt, ngt);
    cvt_range(P.in[I_MS], P.memb + (size_t)4 * 256 * 1024, (size_t)16 * 256 * 256, gt, ngt);
    cvt_range(P.in[I_WQ], P.WqN, (size_t)1024 * 256, gt, ngt);
    for (size_t i = gt; i < (size_t)4 * NTOK * 2 / 4; i += ngt) *(f32x4*)(P.stats + 4 * i) = (f32x4){0.f, 0.f, 0.f, 0.f};
    for (size_t i = gt; i < 4 * 257; i += ngt) { const int h = (int)i / 257, idx = (int)i % 257; P.btab[h * 260 + idx] = P.in[I_RELB][rel_bucket(idx - 128) * 4 + h] * LOG2E; }
    for (size_t e = gt; e < (size_t)64 * 33 * 64; e += ngt) {
        const int p = (int)e & 63, n = (int)(e >> 6) % 33, dg = (int)(e >> 6) / 33;
        const SsmC sc = ssm_consts(P, dg >> 5, dg & 31, p);
        *(f32x2*)(P.TA + 2 * e) = cpow_f(sc.lr, sc.li, n);
        if (n == 0) *(f32x2*)(P.TC + 2 * (size_t)(dg * 64 + p)) = (f32x2){sc.cre, sc.cim};
    }
}
__device__ __forceinline__ void colsum_rows(const bf16_t* Wt, int nrows, const float* gam, const float* bet, float* cs1, float* cs2, int gw, int NGW, int lane) {
    float r[16];
#pragma unroll
    for (int e = 0; e < 16; ++e) r[e] = bet[lane * 16 + e] / gam[lane * 16 + e];
    for (int n = gw; n < nrows; n += NGW) {
        const u32x4 a = *(const u32x4*)(Wt + (size_t)n * 1024 + lane * 16), b = *(const u32x4*)(Wt + (size_t)n * 1024 + lane * 16 + 8);
        const float v[16] = {bflo(a.x), bfhi(a.x), bflo(a.y), bfhi(a.y), bflo(a.z), bfhi(a.z), bflo(a.w), bfhi(a.w), bflo(b.x), bfhi(b.x), bflo(b.y), bfhi(b.y), bflo(b.z), bfhi(b.z), bflo(b.w), bfhi(b.w)};
        float s1 = 0.f, s2 = 0.f;
#pragma unroll
        for (int e = 0; e < 16; ++e) { s1 += v[e]; s2 += v[e] * r[e]; }
#pragma unroll
        for (int o = 1; o < 64; o <<= 1) { s1 += __shfl_xor(s1, o); s2 += __shfl_xor(s2, o); }
        if (lane == 0) { cs1[n] = s1; cs2[n] = s2; }
    }
}
__device__ __forceinline__ void prep_b(const Params& P, int vcu, int G, int tid) {
    const int lane = tid & 63, wave = tid >> 6;
    const int gw = vcu * 8 + wave, NGW = G * 8; const size_t gt = (size_t)vcu * NTHREADS + tid, ngt = (size_t)G * NTHREADS;
    colsum_rows(P.WinT, 2048, P.in[I_G1], P.in[I_B1], P.cs_in, P.cs_in + 2048, gw, NGW, lane);
    colsum_rows(P.W13bT, 5632, P.in[I_G3], P.in[I_B3], P.cs_f2, P.cs_f2 + 5632, gw, NGW, lane);
    for (size_t e = gt; e < (size_t)32 * 2 * 32 * 256; e += ngt) {
        const int g = (int)(e >> 14), dir = (int)(e >> 13) & 1, tau = (int)(e >> 8) & 31, i = (int)(e >> 4) & 15, j = (int)e & 15;
        const int dg = dir * 32 + g; const f32x2* ta = (const f32x2*)P.TA + (size_t)(dg * 33 + tau) * 64; const f32x2* tc = (const f32x2*)P.TC + dg * 64;
        float sum = 0.f;
        for (int p = 0; p < 64; ++p) {
            const int idx = dg * 64 + p; const f32x2 B = {P.in[I_BRE][idx * 16 + j], P.in[I_BIM][idx * 16 + j]};
            const int ci = (dg * 16 + i) * 64 + p; const f32x2 C = {P.in[I_CRE][ci], P.in[I_CIM][ci]};
            sum += cmul(cmul(C, tc[p]), cmul(B, ta[p])).x;
        }
        P.KT[e] = sum;
    }
    for (size_t e = gt; e < (size_t)32 * 256 * 512; e += ngt) {
        const int g = (int)(e / (256 * 512)), row = (int)((e / 512) % 256), k = (int)(e % 512), s = k >> 4, j = k & 15, which = row >> 6, p = row & 63, dir = which >> 1;
        const int n = dir == 0 ? 31 - s : s; const int dg = dir * 32 + g;
        const f32x2 ap = ((const f32x2*)P.TA)[(size_t)(dg * 33 + n) * 64 + p], co = ((const f32x2*)P.TC)[dg * 64 + p];
        const int idx = dg * 64 + p; const f32x2 B = {P.in[I_BRE][idx * 16 + j], P.in[I_BIM][idx * 16 + j]};
        const f32x2 z = cmul(ap, cmul(co, B));
        P.Pcat[e] = (bf16_t)f2bf((which & 1) ? z.y : z.x);
    }
}
__device__ __forceinline__ void mcat_fill(const Params& P, int vcu, int G, int tid) {
    const size_t gt = (size_t)vcu * NTHREADS + tid, ngt = (size_t)G * NTHREADS;
    for (size_t e = gt; e < (size_t)32 * 512 * 768; e += ngt) {
        const int g = (int)(e / (512 * 768)), r = (int)((e / 768) % 512), col = (int)(e % 768), t = r >> 4, i = r & 15;
        float val;
        if (col < 512) { const int s = col >> 4, j = col & 15; val = 0.f;
            if (s <= t) val += P.KT[((size_t)(g * 2 + 0) * 32 + (t - s)) * 256 + i * 16 + j];
            if (s >= t) val += P.KT[((size_t)(g * 2 + 1) * 32 + (s - t)) * 256 + i * 16 + j];
            if (s == t && i == j) val += P.in[I_SSMD][g * 16 + i];
        } else { const int pp = col - 512, which = pp >> 6, p = pp & 63, dir = which >> 1; const int n = dir == 0 ? t + 1 : 32 - t; const int dg = dir * 32 + g;
            const f32x2 ap = ((const f32x2*)P.TA)[(size_t)(dg * 33 + n) * 64 + p];
            const int ci = (dg * 16 + i) * 64 + p; const f32x2 z = cmul((f32x2){P.in[I_CRE][ci], P.in[I_CIM][ci]}, ap);
            val = (which & 1) ? -z.y : z.x; }
        P.Mcat[e] = (bf16_t)f2bf(val);
    }
}

__device__ __forceinline__ void scan_phase(const Params& P, int vcu, int G, int tid) {
    const int lane = tid & 63, wave = tid >> 6;
    for (int item = wave * G + vcu; item < 20 * 64; item += 8 * G) {
        const int seq = item >> 6, g = (item >> 1) & 31, dir = item & 1, p = lane;
        const int L = seq < 4 ? 8192 : 4096, tok0 = seq < 4 ? seq * 8192 : NPROMPT + (seq - 4) * 4096, nch = L / 32, cb = tok0 / 32;
        const f32x2 aT = ((const f32x2*)P.TA)[(size_t)((dir * 32 + g) * 33 + 32) * 64 + p];
        const float* X = BUF_X(P) + (size_t)g * 3072 * 256 + dir * 128 + p; bf16_t* Ac = BUF_ACAT(P) + (size_t)g * 3072 * 768 + 512 + dir * 128 + p;
        float sr = 0.f, si = 0.f;
        for (int c0 = 0; c0 < nch; c0 += 8) {
            float xr[8], xi[8];
#pragma unroll
            for (int k = 0; k < 8; ++k) { const int row = cb + (dir ? nch - 1 - (c0 + k) : c0 + k); xr[k] = X[(size_t)row * 256]; xi[k] = X[(size_t)row * 256 + 64]; }
#pragma unroll
            for (int k = 0; k < 8; ++k) { const int row = cb + (dir ? nch - 1 - (c0 + k) : c0 + k);
                Ac[(size_t)row * 768] = (bf16_t)f2bf(sr); Ac[(size_t)row * 768 + 64] = (bf16_t)f2bf(si);
                const float nr = aT.x * sr - aT.y * si + xr[k], ni = aT.x * si + aT.y * sr + xi[k]; sr = nr; si = ni; }
        }
    }
}

__device__ __forceinline__ int crow(int r, int hi) { return (r & 3) + 8 * (r >> 2) + 4 * hi; }
#define KSWZ(row, colB) ((row) * 256 + ((colB) ^ (((row) & 7) << 4)))
constexpr int AT_K = 0, AT_V = 49152, AT_VSZ = 16384, AT_WS = AT_V + 4 * AT_VSZ, AT_Q = AT_WS + 8 * 512, AT_BT = AT_Q + 32768;
static_assert(AT_BT + 260 * 4 <= LDS_BYTES, "attention LDS map");
#define MFMA32(a, b, c) __builtin_amdgcn_mfma_f32_32x32x16_bf16((a), (b), (c), 0, 0, 0)
#define GLDS16(gptr, ldsptr) __builtin_amdgcn_global_load_lds((const unsigned*)(gptr), (LAS unsigned*)(ldsptr), 16, 0, 0)
__device__ __forceinline__ bf16x8 pack8(const f32x16& p, int s) {
    u32x4 w; w.x = pk2(p[8 * s + 0], p[8 * s + 1]); w.y = pk2(p[8 * s + 2], p[8 * s + 3]); w.z = pk2(p[8 * s + 4], p[8 * s + 5]); w.w = pk2(p[8 * s + 6], p[8 * s + 7]);
    return __builtin_bit_cast(bf16x8, w);
}
__device__ __forceinline__ void tile_bias(int t, int qw, float btL, float btR, bool& nearb, float& cb) { const int kmin = t * 64; const bool fl = (kmin + 63 - qw <= -128), fr = (kmin - (qw + 31) >= 128); nearb = !(fl || fr); cb = fl ? btL : btR; }
__device__ __forceinline__ void attn_unit(const Params& P, LAS unsigned char* lds, int seq, int h, int qb, float lam, int tid_in) {
    int tid = tid_in; asm volatile("" : "+v"(tid));
    const int lane = tid & 63, r32 = lane & 31, hi = lane >> 5; const int wid = __builtin_amdgcn_readfirstlane(tid >> 6);
    const int qg = wid >> 1, m = wid & 1;
    const int L = seq < 4 ? 8192 : 4096, tok0 = seq < 4 ? seq * 8192 : NPROMPT + (seq - 4) * 4096, NT = L / 64;
    const int q0 = qb * 128, qw = q0 + qg * 32;
    LAS unsigned char* Ks = lds + AT_K; LAS unsigned char* Vs = lds + AT_V; LAS float* wsf = (LAS float*)(lds + AT_WS + wid * 512);
    LAS unsigned char* Qs = lds + AT_Q; LAS float* bt = (LAS float*)(lds + AT_BT);
    for (int i = tid; i < 257; i += NTHREADS) bt[i] = P.btab[h * 260 + i];
#pragma unroll
    for (int i = 0; i < 4; ++i) { const int idx = tid + NTHREADS * i, row = idx >> 4, ch = idx & 15;
        const u32x4 v = *(const u32x4*)(BUF_Q(P) + (size_t)(tok0 + q0 + row) * 512 + h * 128 + ch * 8); *(LAS u32x4*)(Qs + KSWZ(row, ch * 16)) = v; }
    unsigned ko0, ko1, vo0, vo1;
    { int j = 2 * wid, row = 4 * j + (lane >> 4), lc = (lane & 15) ^ (row & 7); ko0 = (unsigned)(row * 512 + lc * 8) * 2u;
      j = 2 * wid + 1; row = 4 * j + (lane >> 4); lc = (lane & 15) ^ (row & 7); ko1 = (unsigned)(row * 512 + lc * 8) * 2u;
      j = 2 * wid; row = 8 * j + (lane >> 3); lc = (lane & 7) ^ ((row >> 1) & 7); vo0 = (unsigned)(row * NTOK + lc * 8) * 2u;
      j = 2 * wid + 1; row = 8 * j + (lane >> 3); lc = (lane & 7) ^ ((row >> 1) & 7); vo1 = (unsigned)(row * NTOK + lc * 8) * 2u; }
    const char* kbase = (const char*)(BUF_K(P) + (size_t)tok0 * 512 + h * 128);
    const char* vbase = (const char*)(BUF_VT(P) + (size_t)(h * 128) * NTOK + tok0);
    const int pdst = wid * 2048;
#define ATT_DMA(t, koff_, voff_) do { const char* kb_ = kbase + (size_t)(t) * (64 * 512 * 2); const char* vb_ = vbase + (size_t)(t) * 128; \
                             GLDS16(kb_ + ko0, Ks + (koff_) + pdst); GLDS16(kb_ + ko1, Ks + (koff_) + pdst + 1024); \
                             GLDS16(vb_ + vo0, Vs + (voff_) + pdst); GLDS16(vb_ + vo1, Vs + (voff_) + pdst + 1024); } while (0)
    asm volatile("s_waitcnt vmcnt(0) lgkmcnt(0)" ::: "memory");
    ATT_DMA(0, 0, 0); ATT_DMA(1, 16384, AT_VSZ); ATT_DMA(2, 32768, 2 * AT_VSZ);
    asm volatile("s_waitcnt vmcnt(4) lgkmcnt(0)" ::: "memory");
    __builtin_amdgcn_s_barrier(); asm volatile("" ::: "memory");
    f32x16 O[4];
#pragma unroll
    for (int d = 0; d < 4; ++d)
#pragma unroll
        for (int i = 0; i < 16; ++i) O[d][i] = 0.f;
    float mrun = 0.f, lsum = 0.f;
    const int qpos = qw + r32;
    const int vsw = (r32 >> 1) & 7;
    int vcur = 0, v1 = AT_VSZ, v2 = 2 * AT_VSZ, v3 = 3 * AT_VSZ; int k1 = 16384, k2 = 32768, k3 = 0;
    bf16x8 pa[4];
#define ATT_S(P0, P1, koff_, cinit_) do { _Pragma("unroll") for (int i = 0; i < 16; ++i) { P0[i] = (cinit_); P1[i] = (cinit_); } \
        _Pragma("unroll") for (int d0 = 0; d0 < 4; ++d0) { const int colB = (m * 64 + d0 * 16 + hi * 8) * 2; \
            const bf16x8 k0 = *(const LAS bf16x8*)(Ks + (koff_) + KSWZ(r32, colB)); const bf16x8 k1_ = *(const LAS bf16x8*)(Ks + (koff_) + KSWZ(32 + r32, colB)); \
            const bf16x8 qf = *(const LAS bf16x8*)(Qs + KSWZ(qg * 32 + r32, colB)); \
            P0 = MFMA32(k0, qf, P0); P1 = MFMA32(k1_, qf, P1); asm volatile("" ::: "memory"); } } while (0)
#define ATT_PV(voff_) do { _Pragma("unroll") for (int d0 = 0; d0 < 4; ++d0) _Pragma("unroll") for (int s = 0; s < 4; ++s) { const LAS unsigned char* vr = Vs + (voff_) + (32 * d0 + r32) * 128; \
        const bf16x8 vf = *(const LAS bf16x8*)(vr + (((2 * s + hi) ^ vsw) << 4));     \
        O[d0] = MFMA32(pa[s], vf, O[d0]); if (s == 3) asm volatile("" ::: "memory"); } } while (0)
#define ATT_STEP(t, PC0, PC1, PN0, PN1, DOMAX) do { \
        if ((t) + 3 < NT) ATT_DMA((t) + 3, k3, v3); \
        bool near_c; float cb_c; tile_bias((t), qw, btL, btR, near_c, cb_c); (void)cb_c; \
        if ((t) + 1 < NT) { const int t1_ = (t) + 1; const int kmin_n = t1_ * 64; const bool fl_n = (kmin_n + 63 - qw <= -128), fr_n = (kmin_n - (qw + 31) >= 128); \
            const float cin = ((fl_n || fr_n) ? (fl_n ? btL : btR) : 0.f) - mrun; ATT_S(PN0, PN1, k1, cin); } \
        if (near_c) { int qp_ = qpos, hn_ = hi; asm volatile("" : "+v"(qp_), "+v"(hn_)); const int kmin = (t) * 64; \
            _Pragma("unroll") for (int i = 0; i < 16; ++i) { const int rel = kmin + crow(i, hn_) - qp_; const int i0 = min(max(rel, -128), 128) + 128, i1 = min(max(rel + 32, -128), 128) + 128; PC0[i] += bt[i0]; PC1[i] += bt[i1]; if ((i & 3) == 3) asm volatile("" ::: "memory"); } } \
        float mx = 0.f;     \
        if (DOMAX) { mx = fmaxf(fmaxf(PC0[0], PC1[0]), PC0[1]); \
        _Pragma("unroll") for (int i = 1; i < 15; i += 2) { mx = fmaxf(fmaxf(mx, PC1[i]), PC0[i + 1]); mx = fmaxf(fmaxf(mx, PC1[i + 1]), PC0[i + 2 < 16 ? i + 2 : 15]); } \
        mx = fmaxf(mx, PC1[15]); \
        { auto rr_ = __builtin_amdgcn_permlane32_swap(__float_as_uint(mx), __float_as_uint(mx), false, false); mx = fmaxf(__uint_as_float(rr_[0]), __uint_as_float(rr_[1])); } }     \
        if ((DOMAX) && ((t) == 0 || __any(mx > 4.f))) { \
            const float dl = ((t) == 0) ? mx : fmaxf(mx, 0.f); const float al = __builtin_amdgcn_exp2f(-dl); mrun += dl; \
            _Pragma("unroll") for (int i = 0; i < 16; ++i) { PC0[i] -= dl; PC1[i] -= dl; } \
            if ((t) + 1 < NT) { _Pragma("unroll") for (int i = 0; i < 16; ++i) { PN0[i] -= dl; PN1[i] -= dl; } } \
            if ((t) != 0) { lsum *= al; if (hi == 0) wsf[r32] = al; LDS_WAIT(); \
                _Pragma("unroll") for (int i = 0; i < 16; ++i) { const float a = wsf[crow(i, hi)]; _Pragma("unroll") for (int d = 0; d < 4; ++d) O[d][i] *= a; } } \
        } \
        float ps = 0.f; \
        _Pragma("unroll") for (int i = 0; i < 16; ++i) { PC0[i] = __builtin_amdgcn_exp2f(PC0[i]); PC1[i] = __builtin_amdgcn_exp2f(PC1[i]); ps += PC0[i] + PC1[i]; } \
        lsum += ps; \
        pa[0] = pack8(PC0, 0); pa[1] = pack8(PC0, 1); pa[2] = pack8(PC1, 0); pa[3] = pack8(PC1, 1); \
        ATT_PV(vcur); \
        if ((t) + 3 < NT) asm volatile("s_waitcnt vmcnt(4) lgkmcnt(0)" ::: "memory"); else asm volatile("s_waitcnt vmcnt(0) lgkmcnt(0)" ::: "memory"); \
        __builtin_amdgcn_s_barrier(); asm volatile("" ::: "memory"); \
        { const int tv = vcur; vcur = v1; v1 = v2; v2 = v3; v3 = tv; const int tk = k1; k1 = k2; k2 = k3; k3 = tk; } \
    } while (0)
    f32x16 pA0, pA1, pB0, pB1;
    const float btL = bt[0], btR = bt[256];
    { bool near0; float cb0; tile_bias(0, qw, btL, btR, near0, cb0); const float cin0 = near0 ? 0.f : cb0; ATT_S(pA0, pA1, 0, cin0); }
    asm volatile("s_waitcnt lgkmcnt(0)" ::: "memory"); __builtin_amdgcn_s_barrier(); asm volatile("" ::: "memory");
    for (int t = 0; t < NT; t += 2) {
        ATT_STEP(t, pA0, pA1, pB0, pB1, 1);
        ATT_STEP(t + 1, pB0, pB1, pA0, pA1, 0);
    }
    asm volatile("s_waitcnt lgkmcnt(0)" ::: "memory");
    __syncthreads();
#undef ATT_S
#undef ATT_STEP
#undef ATT_DMA
#undef ATT_PV
    int r32e = r32, hie = hi, lanee = lane; asm volatile("" : "+v"(r32e), "+v"(hie), "+v"(lanee));
    lsum += __shfl_xor(lsum, 32); if (hie == 0) wsf[r32e] = 1.f / lsum;
    LDS_WAIT();
    LAS float* xb = (LAS float*)(lds + AT_K) + qg * 4096 + lanee;
#pragma unroll
    for (int i = 0; i < 16; ++i) { const float il = wsf[crow(i, hie)];
#pragma unroll
        for (int d = 0; d < 4; ++d) O[d][i] *= il; }
    if (m == 1) {
#pragma unroll
        for (int d = 0; d < 4; ++d)
#pragma unroll
            for (int i = 0; i < 16; ++i) xb[(d * 16 + i) * 64] = O[d][i];
    }
    LDS_WAIT();
    __syncthreads();
    if (m == 0) {
        float ssq[16];
#pragma unroll
        for (int i = 0; i < 16; ++i) { float a = 0.f;
#pragma unroll
            for (int d = 0; d < 4; ++d) { const float v = O[d][i] - lam * xb[(d * 16 + i) * 64]; O[d][i] = v; a += v * v; }
            ssq[i] = a; }
#pragma unroll
        for (int i = 0; i < 16; ++i) {
#pragma unroll
            for (int o = 1; o < 32; o <<= 1) ssq[i] += __shfl_xor(ssq[i], o);
            ssq[i] = rsqrtf(ssq[i] * (1.f / 128.f) + 1e-5f); }
        bf16_t* outp = BUF_CAT(P) + (size_t)(tok0 + qw) * 1024 + h * 128 + r32e;
#pragma unroll
        for (int d = 0; d < 4; ++d) { const float gs = P.in[I_SUBG][32 * d + r32e] * 0.8f;
#pragma unroll
            for (int i = 0; i < 16; ++i) outp[(size_t)crow(i, hie) * 1024 + 32 * d] = (bf16_t)f2bf(O[d][i] * ssq[i] * gs); }
    }
    LDS_WAIT();
    __syncthreads();
}
__device__ __forceinline__ void attn_phase(const Params& P, LAS unsigned char* lds, int vcu, int G, int tid) {
    const int lane = tid & 63;
    float a = P.in[I_DLAM][lane] * P.in[I_DLAM][64 + lane], b = P.in[I_DLAM][128 + lane] * P.in[I_DLAM][192 + lane];
#pragma unroll
    for (int o = 1; o < 64; o <<= 1) { a += __shfl_xor(a, o); b += __shfl_xor(b, o); }
    const float lam = expf(a) - expf(b) + 0.2f;
    for (int u = vcu; u < 1024; u += G) attn_unit(P, lds, u >> 8, (u >> 6) & 3, u & 63, lam, tid);
    for (int u = vcu; u < 2048; u += G) attn_unit(P, lds, 4 + (u >> 7), (u >> 5) & 3, u & 31, lam, tid);
}

__device__ __forceinline__ void softmax_pass(const Params& P, int vcu, int G, int tid) {
    const int lane = tid & 63, wave = tid >> 6; const int gw = vcu * 8 + wave, NGW = G * 8;
    for (int row = gw; row < NTOK; row += NGW) {
        bf16_t* p = BUF_PM(P) + (size_t)row * 1024 + lane * 16;
        const u32x4 a = *(const u32x4*)p, b = *(const u32x4*)(p + 8);
        float v[16] = {bflo(a.x), bfhi(a.x), bflo(a.y), bfhi(a.y), bflo(a.z), bfhi(a.z), bflo(a.w), bfhi(a.w), bflo(b.x), bfhi(b.x), bflo(b.y), bfhi(b.y), bflo(b.z), bfhi(b.z), bflo(b.w), bfhi(b.w)};
        float mx = v[0];
#pragma unroll
        for (int e = 1; e < 16; ++e) mx = fmaxf(mx, v[e]);
#pragma unroll
        for (int o = 1; o < 16; o <<= 1) mx = fmaxf(mx, __shfl_xor(mx, o));
        float l = 0.f;
#pragma unroll
        for (int e = 0; e < 16; ++e) { v[e] = __builtin_amdgcn_exp2f(v[e] - mx); l += v[e]; }
#pragma unroll
        for (int o = 1; o < 16; o <<= 1) l += __shfl_xor(l, o);
        const float il = 1.f / l;
        u32x4 w0, w1; w0.x = pk2(v[0] * il, v[1] * il); w0.y = pk2(v[2] * il, v[3] * il); w0.z = pk2(v[4] * il, v[5] * il); w0.w = pk2(v[6] * il, v[7] * il);
        w1.x = pk2(v[8] * il, v[9] * il); w1.y = pk2(v[10] * il, v[11] * il); w1.z = pk2(v[12] * il, v[13] * il); w1.w = pk2(v[14] * il, v[15] * il);
        *(u32x4*)p = w0; *(u32x4*)(p + 8) = w1;
    }
}

__device__ __forceinline__ void final_ln(const Params& P, int vcu, int G, int tid) {
    const int lane = tid & 63, wave = tid >> 6; const int gw = vcu * 8 + wave, NGW = G * 8;
    f32x4 gv[4], bv[4];
#pragma unroll
    for (int j = 0; j < 4; ++j) { gv[j] = *(const f32x4*)(P.in[I_G4] + lane * 4 + 256 * j); bv[j] = *(const f32x4*)(P.in[I_B4] + lane * 4 + 256 * j); }
    for (int row = gw; row < NTOK; row += NGW) {
        float* xr = P.out + (size_t)row * 1024 + lane * 4; f32x4 v[4]; float s = 0.f;
#pragma unroll
        for (int j = 0; j < 4; ++j) { v[j] = *(const f32x4*)(xr + 256 * j); s += (v[j][0] + v[j][1]) + (v[j][2] + v[j][3]); }
#pragma unroll
        for (int o = 1; o < 64; o <<= 1) s += __shfl_xor(s, o);
        const float mean = s * (1.f / 1024.f); float q = 0.f;
#pragma unroll
        for (int j = 0; j < 4; ++j) { v[j] = v[j] - mean; q += (v[j][0] * v[j][0] + v[j][1] * v[j][1]) + (v[j][2] * v[j][2] + v[j][3] * v[j][3]); }
#pragma unroll
        for (int o = 1; o < 64; o <<= 1) q += __shfl_xor(q, o);
        const float rstd = rsqrtf(q * (1.f / 1024.f) + LN_EPS);
#pragma unroll
        for (int j = 0; j < 4; ++j) *(f32x4*)(xr + 256 * j) = v[j] * rstd * gv[j] + bv[j];
    }
}

__device__ __forceinline__ GD make_gd(const Params& P, int gi) {
    GD g; g.a_s1 = g.a_s2 = g.b_s1 = g.b_s2 = 0; g.gdiv = 1; g.bseq = 0; g.ngrp = 1; g.stage = 0; g.perm = 1; g.K = 1024; g.lda = g.ldb = 2048; g.nM = 384; g.nN = 4; g.mode = M_RESID; g.A = nullptr; g.B = nullptr;
    switch (gi) {
    case 0: g.A = (const char*)P.memb; g.B = (const char*)P.WkvT; g.nM = 20; g.nN = 8; g.mode = M_KVMEM; break;
    case 1: g.A = (const char*)BUF_XB(P); g.B = (const char*)P.W13T; g.nN = 22; g.mode = M_SWIGLU; g.stage = 1; break;
    case 2: g.A = (const char*)P.kvm; g.lda = 4096; g.a_s1 = 256 * 4096; g.a_s2 = 512; g.B = (const char*)P.WqN; g.b_s2 = 512; g.gdiv = 4; g.K = 256; g.nM = 1; g.nN = 4; g.ngrp = 80; g.mode = M_WQK; break;
    case 3: g.A = (const char*)P.WoT; g.a_s2 = 512; g.B = (const char*)P.kvm + 2048; g.ldb = 4096; g.b_s1 = 256 * 4096; g.b_s2 = 512; g.gdiv = 4; g.K = 256; g.nM = 4; g.nN = 1; g.ngrp = 80; g.mode = M_VWO; break;
    case 4: g.A = (const char*)BUF_H1(P); g.B = (const char*)P.W2T; g.lda = g.ldb = 5632; g.K = 2816; g.stage = 1; g.perm = 0; break;
    case 5: g.A = (const char*)BUF_Y1B(P); g.B = (const char*)P.WinT; g.nN = 6; g.mode = M_QKU; break;
    case 6: g.A = (const char*)(P.WinT + 1536 * 1024); g.B = (const char*)BUF_Y1B(P); g.nM = 2; g.nN = 384; g.mode = M_VT; break;
    case 7: g.A = (const char*)BUF_ACAT(P); g.lda = 1536; g.a_s1 = 3072 * 1536; g.B = (const char*)P.Pcat; g.ldb = 1024; g.b_s1 = 256 * 1024; g.K = 512; g.nM = 12; g.nN = 1; g.ngrp = 32; g.mode = M_SSM1; g.perm = 0; break;
    case 8: g.A = (const char*)BUF_ACAT(P); g.lda = 1536; g.a_s1 = 3072 * 1536; g.B = (const char*)P.Mcat; g.ldb = 1536; g.b_s1 = 512 * 1536; g.K = 768; g.nM = 12; g.nN = 2; g.ngrp = 32; g.mode = M_SSM3; break;
    case 9: g.A = (const char*)BUF_Z(P); g.B = (const char*)P.GluT; g.lda = g.ldb = 1024; g.K = 512; g.nN = 2; g.mode = M_GLU; break;
    case 10: g.A = (const char*)BUF_CAT(P); g.B = (const char*)P.WoutT; g.stage = 2; g.perm = 0; break;
    case 11: g.A = (const char*)BUF_Y2B(P); g.B = (const char*)P.Wqk; g.b_s1 = 1024 * 2048; g.bseq = 1; g.mode = M_SCORES; break;
    case 12: g.A = (const char*)BUF_PM(P); g.B = (const char*)P.VWo; g.b_s1 = 1024 * 2048; g.bseq = 1; g.stage = 3; g.perm = 0; break;
    case 13: g.A = (const char*)BUF_Y3B(P); g.B = (const char*)P.W13bT; g.nN = 22; g.mode = M_SWIGLU; g.stage = 4; break;
    default: g.A = (const char*)BUF_H2(P); g.B = (const char*)P.W2bT; g.lda = g.ldb = 5632; g.K = 2816; g.stage = 4; g.perm = 0; break;
    }
    return g;
}

#define XB_TMO      128
#define XB_XCNT(j)  (256  + 64 * (j))
#define XB_XSUB(j)  (1280 + 64 * (j))
#define XB_XGEN(j)  (2304 + 64 * (j))
#define XB_TOP      3328
#define XB_TOPGEN   3392
#define XCD_BAR_WORDS 3456
#define XB_SPIN_CAP (1u << 18)
__device__ __forceinline__ unsigned xb_ld(unsigned* p)              { return __hip_atomic_load(p, __ATOMIC_RELAXED, __HIP_MEMORY_SCOPE_AGENT); }
__device__ __forceinline__ unsigned xb_add(unsigned* p, unsigned v) { return __hip_atomic_fetch_add(p, v, __ATOMIC_RELAXED, __HIP_MEMORY_SCOPE_AGENT); }
__device__ __forceinline__ unsigned xb_xcc_id() { return (unsigned)__builtin_amdgcn_s_getreg((3 << 11) | 20) & 0xFu; }
#define XB_SPIN(cond, bar) do { unsigned _sp = 0; while (cond) { __builtin_amdgcn_s_sleep(1); \
    if ((++_sp & 255u) == 0u) { if (xb_ld(&(bar)[XB_TMO])) break; if (_sp > XB_SPIN_CAP) { atomicAdd(&(bar)[XB_TMO], 1u); break; } } } } while (0)
struct XcdBarrier { unsigned* bar; unsigned x; volatile LAS unsigned* st; };
__device__ __forceinline__ void xcd_barrier_complete(unsigned* bar, unsigned x, unsigned& nloc, unsigned& nx) {
    const unsigned G = gridDim.x * gridDim.y * gridDim.z;
    unsigned sum, cnt, mine, sp = 0u;
    for (;;) {
        sum = 0u; cnt = 0u; mine = 0u;
#pragma unroll
        for (unsigned j = 0; j < 16; ++j) { const unsigned c = xb_ld(&bar[XB_XCNT(j)]); sum += c; cnt += (c > 0u) ? 1u : 0u; mine = (j == x) ? c : mine; }
        if (sum == G) break;
        __builtin_amdgcn_s_sleep(1);
        if ((++sp & 255u) == 0u) { if (xb_ld(&bar[XB_TMO])) break; if (sp > XB_SPIN_CAP) { atomicAdd(&bar[XB_TMO], 1u); break; } }
    }
    nloc = mine > 0u ? mine : 1u; nx = cnt > 0u ? cnt : 1u;
}
__device__ __forceinline__ void xcd_barrier(unsigned* bar, volatile LAS unsigned* st) {
    asm volatile("s_waitcnt vmcnt(0)" ::: "memory");
    __syncthreads();
    if (threadIdx.x == 0) {
        const unsigned x = xb_xcc_id();
        __builtin_amdgcn_s_waitcnt(0);
        unsigned nloc = st[0], nx = st[1];
        if (nloc == 0u) { xcd_barrier_complete(bar, x, nloc, nx); st[0] = nloc; st[1] = nx; }
        const unsigned old = xb_add(&bar[XB_XSUB(x)], 1u);
        const unsigned gen = old / nloc;
        if (old + 1u == (gen + 1u) * nloc) {
            __builtin_amdgcn_fence(__ATOMIC_RELEASE, "agent");
            asm volatile("s_waitcnt vmcnt(0)" ::: "memory");
            const unsigned og = xb_add(&bar[XB_TOP], 1u);
            const unsigned tg = og / nx;
            if (og + 1u == (tg + 1u) * nx) xb_add(&bar[XB_TOPGEN], 1u);
            else XB_SPIN(xb_ld(&bar[XB_TOPGEN]) == tg, bar);
            __builtin_amdgcn_fence(__ATOMIC_ACQUIRE, "agent");
            xb_add(&bar[XB_XGEN(x)], 1u);
            asm volatile("s_waitcnt vmcnt(0)" ::: "memory");
        } else {
            XB_SPIN(xb_ld(&bar[XB_XGEN(x)]) == gen, bar);
            __builtin_amdgcn_fence(__ATOMIC_ACQUIRE, "agent");
            asm volatile("s_waitcnt vmcnt(0)" ::: "memory");
        }
    }
    __syncthreads();
}

template <int PH> __device__ __forceinline__ void run_phase(LAS unsigned char* lds, int vcu, int G, int bx) {
    const Params* Pk = (const Params*)__builtin_amdgcn_kernarg_segment_ptr(); asm volatile("" : "+s"(Pk));
    int tz = 0; asm volatile("" : "+v"(tz)); const int tid = (int)threadIdx.x + tz;
    const Params& Q = *Pk;
    constexpr int gfirst[14] = {0, 0, 2, 5, 7, 8, 8, 9, 10, 11, 12, 13, 14, 15};
    if constexpr (PH == 0) prep_a(Q, lds, vcu, G, tid);
    else if constexpr (PH == 1) prep_b(Q, vcu, G, tid);
    else if constexpr (PH == 2) mcat_fill(Q, vcu, G, tid);
    else if constexpr (PH == 3) colsum_rows(Q.Wqk, 20 * 1024, Q.in[I_G2], Q.in[I_B2], Q.cs_m, Q.cs_m + 20 * 1024, vcu * 8 + (tid >> 6), G * 8, tid & 63);
    else if constexpr (PH == 5) { scan_phase(Q, vcu, G, tid); attn_phase(Q, lds, vcu, G, tid); }
    if constexpr (gfirst[PH + 1] > gfirst[PH]) {
        __syncthreads();
#pragma unroll 1
        for (int gi = gfirst[PH]; gi < gfirst[PH + 1]; ++gi) { const GD g = make_gd(Q, gi); gemm_phase(lds, g, Q, G, bx, tid); }
    }
    if constexpr (PH == 0) cg::this_grid().sync();
    else if constexpr (PH < 12) xcd_barrier(Q.barw, (volatile LAS unsigned*)(lds + LDS_BYTES - 16));
}
__global__ void __launch_bounds__(NTHREADS, 2) mega_fwd(Params P) {
    extern __shared__ __attribute__((aligned(16))) unsigned char lds_raw[];
    LAS unsigned char* lds = (LAS unsigned char*)lds_raw;
    const int G = gridDim.x, bx = blockIdx.x;
    const int vcu = (G % 8 == 0) ? (bx % 8) * (G / 8) + bx / 8 : bx;
    if (threadIdx.x == 0) { volatile LAS unsigned* st = (volatile LAS unsigned*)(lds + LDS_BYTES - 16); st[0] = 0u; st[1] = 0u; (void)xb_add(&P.barw[XB_XCNT(xb_xcc_id())], 1u); }
    __syncthreads();
    run_phase<0>(lds, vcu, G, bx); run_phase<1>(lds, vcu, G, bx); run_phase<2>(lds, vcu, G, bx); run_phase<3>(lds, vcu, G, bx);
    run_phase<4>(lds, vcu, G, bx); run_phase<5>(lds, vcu, G, bx); run_phase<6>(lds, vcu, G, bx); run_phase<7>(lds, vcu, G, bx);
    run_phase<8>(lds, vcu, G, bx); run_phase<9>(lds, vcu, G, bx); run_phase<10>(lds, vcu, G, bx); run_phase<11>(lds, vcu, G, bx);
    run_phase<12>(lds, vcu, G, bx);
}

extern "C" void kernel_launch(void* const* d_in, const int* in_sizes, int n_in, void* d_out, int out_size, void* d_ws, size_t ws_size, hipStream_t stream) {
    static int grid = 0;
    if (grid == 0) {
        int dev = 0, cus = 0, per_cu = 0;
        (void)hipGetDevice(&dev); (void)hipDeviceGetAttribute(&cus, hipDeviceAttributeMultiprocessorCount, dev);
        (void)hipFuncSetAttribute((const void*)mega_fwd, hipFuncAttributeMaxDynamicSharedMemorySize, LDS_BYTES);
        (void)hipOccupancyMaxActiveBlocksPerMultiprocessor(&per_cu, (const void*)mega_fwd, NTHREADS, LDS_BYTES);
        if (per_cu < 1) per_cu = 1;
        grid = (cus > 0 ? cus : 256) * per_cu;
        if (ws_size < 976 * MiB) fprintf(stderr, "kernel_launch: workspace too small (%zu)\n", ws_size);
    }
    Params P{};
    for (int i = 0; i < 34; ++i) P.in[i] = (const float*)d_in[i];
    P.out = (float*)d_out;
    char* ws = (char*)d_ws; size_t off = 0;
    auto take = [&](size_t bytes) { char* p = ws + off; off += (bytes + 255) & ~(size_t)255; return p; };
    P.W13T = (bf16_t*)take(5632 * 1024 * 2); P.W2T = (bf16_t*)take(1024 * 2816 * 2); P.WinT = (bf16_t*)take(2048 * 1024 * 2); P.GluT = (bf16_t*)take(512 * 512 * 2);
    P.WoutT = (bf16_t*)take(1024 * 1024 * 2); P.WqN = (bf16_t*)take(1024 * 1024 * 2); P.WkvT = (bf16_t*)take(2048 * 1024 * 2); P.WoT = (bf16_t*)take(1024 * 1024 * 2);
    P.W13bT = (bf16_t*)take(5632 * 1024 * 2); P.W2bT = (bf16_t*)take(1024 * 2816 * 2);
    P.memb = (bf16_t*)take(5120 * 1024 * 2); P.kvm = (bf16_t*)take(5120 * 2048 * 2); P.Wqk = (bf16_t*)take((size_t)20 * 1024 * 1024 * 2); P.VWo = (bf16_t*)take((size_t)20 * 1024 * 1024 * 2);
    P.Mcat = (bf16_t*)take((size_t)32 * 512 * 768 * 2); P.Pcat = (bf16_t*)take((size_t)32 * 256 * 512 * 2);
    P.KT = (float*)take((size_t)32 * 2 * 32 * 256 * 4); P.stats = (float*)take((size_t)4 * NTOK * 2 * 4);
    P.cs_in = (float*)take(2 * 2048 * 4); P.cs_f2 = (float*)take(2 * 5632 * 4); P.cs_m = (float*)take(2 * 20 * 1024 * 4); P.btab = (float*)take(4 * 260 * 4); P.TA = (float*)take((size_t)64 * 33 * 64 * 8); P.TC = (float*)take((size_t)64 * 64 * 8); P.barw = (unsigned*)take(XCD_BAR_WORDS * 4 + 384 * 4); P.pcnt = P.barw + XCD_BAR_WORDS;
    P.SB = ws + 208 * MiB; P.SC = P.SB + 192 * MiB; P.SA = P.SC + 384 * MiB;
    P.ph_lo = 0; P.ph_hi = 16;
    (void)hipMemsetAsync(P.barw, 0, XCD_BAR_WORDS * 4 + 384 * 4, stream);
    void* args[] = {&P};
    hipError_t e = hipLaunchCooperativeKernel((const void*)mega_fwd, dim3(grid), dim3(NTHREADS), args, LDS_BYTES, stream);
    if (e != hipSuccess) fprintf(stderr, "cooperative launch failed: %s (grid %d)\n", hipGetErrorString(e), grid);
}
```
